# Optimizing an MI355X kernel written in HIP

```python
import math
import jax, jax.numpy as jnp
from jax import lax
import numpy as np

D_MODEL = 4096
BATCH = 1
SEQ = 8192
DEPTH = 2

CHUNK = 64

MIX_HALF = D_MODEL // 2
HEAD_DIM = 128
N_ATTN_HEADS = MIX_HALF // HEAD_DIM
Q_BLOCK = 128
FORGET_BIAS = 3.0
POOL_WINDOWS = (2, 4, 8, 16)
POOL_GROUPS = len(POOL_WINDOWS)
POOL_GROUP_DIM = MIX_HALF // POOL_GROUPS
CONV_WIDTH = MIX_HALF
CONV_K = 3
SGU_WIDTH = MIX_HALF
SGU_CHUNK = 128
SGU_HEADS = 16
SGU_HEAD_DIM = SGU_WIDTH // SGU_HEADS
D_FF = ((8 * D_MODEL // 3 + 255) // 256) * 256
FFN_CONV_K = 3
EPS = 1e-6

EVEN_IN = 3 * MIX_HALF + N_ATTN_HEADS + MIX_HALF
ODD_IN = 3 * CONV_WIDTH + 2 * SGU_WIDTH

kernel_name = "hybrid_fox_pool_conv_sgu_trunk"


def rmsnorm(x, g):
    xf = x.astype(jnp.float32)
    y = xf * lax.rsqrt(jnp.mean(xf * xf, axis=-1, keepdims=True) + EPS)
    return (y * g.astype(jnp.float32)).astype(x.dtype)


def causal_dwconv(x, w):
    k = w.shape[0]
    s = x.shape[1]
    xp = jnp.pad(x, ((0, 0), (k - 1, 0), (0, 0)))
    y = w[0] * xp[:, 0:s]
    for i in range(1, k):
        y = y + w[i] * xp[:, i:i + s]
    return y


def forgetting_attention(q, k, v, f_logit, b_f, q_gain, k_gain):
    b, s, h, d = q.shape
    log_f = jax.nn.log_sigmoid(f_logit.astype(jnp.float32) + b_f.astype(jnp.float32))
    cum = jnp.cumsum(log_f, axis=1).transpose(0, 2, 1)
    q = rmsnorm(q, q_gain)
    k = rmsnorm(k, k_gain)
    scale = 1.0 / math.sqrt(d)
    nblk = s // Q_BLOCK
    q_blocks = q.reshape(b, nblk, Q_BLOCK, h, d).transpose(1, 0, 2, 3, 4)
    cum_blocks = cum.reshape(b, h, nblk, Q_BLOCK).transpose(2, 0, 1, 3)
    kpos = jnp.arange(s)

    def one_block(args):
        qb, cq, i = args
        qpos = i * Q_BLOCK + jnp.arange(Q_BLOCK)
        logits = jnp.einsum('bqhd,bkhd->bhqk', qb, k,
                            preferred_element_type=jnp.float32) * scale
        logits = logits + (cq[:, :, :, None] - cum[:, :, None, :])
        logits = jnp.where(kpos[None, :] <= qpos[:, None], logits, -1e30)
        p = jax.nn.softmax(logits, axis=-1)
        return jnp.einsum('bhqk,bkhd->bqhd', p.astype(v.dtype), v)

    out = lax.map(one_block, (q_blocks, cum_blocks, jnp.arange(nblk)))
    return out.transpose(1, 0, 2, 3, 4).reshape(b, s, h * d)


def multiscale_pool(z, pool_w, pool_scale):
    b, s, _ = z.shape
    zg = z.reshape(b, s, POOL_GROUPS, POOL_GROUP_DIM)
    cs = jnp.cumsum(zg.astype(jnp.float32), axis=1)
    pos = jnp.arange(1, s + 1, dtype=jnp.float32)
    outs = []
    for g, w in enumerate(POOL_WINDOWS):
        c = cs[:, :, g]
        c_prev = jnp.pad(c, ((0, 0), (w, 0), (0, 0)))[:, :s]
        cnt = jnp.minimum(pos, float(w))[None, :, None]
        pooled = (c - c_prev) / cnt - zg[:, :, g].astype(jnp.float32)
        outs.append(jnp.einsum('bsc,cd->bsd', pooled.astype(z.dtype), pool_w[g]))
    return jnp.concatenate(outs, axis=-1) * pool_scale


def short_gated_conv(v, gate_b, gate_c, conv_w):
    return gate_b * causal_dwconv(gate_c * v, conv_w)


def spatial_gating(z, norm_g, w_s, b_s):
    z = jax.nn.gelu(z, approximate=False)
    u, v = jnp.split(z, 2, axis=-1)
    v = rmsnorm(v, norm_g)
    b, s, _ = v.shape
    n = s // SGU_CHUNK
    vc = v.reshape(b, n, SGU_CHUNK, SGU_HEADS, SGU_HEAD_DIM)
    w = jnp.tril(w_s)
    mixed = jnp.einsum('hts,bnshc->bnthc', w, vc) + b_s.T[None, None, :, :, None]
    return u * mixed.reshape(b, s, SGU_WIDTH)


def even_mixer(h, w_in, b_f, q_gain, k_gain, pool_w, pool_scale, w_out):
    b, s, _ = h.shape
    p = h @ w_in
    q, k, v, f_logit, zp = jnp.split(
        p, [MIX_HALF, 2 * MIX_HALF, 3 * MIX_HALF, 3 * MIX_HALF + N_ATTN_HEADS], axis=-1)
    shp = (b, s, N_ATTN_HEADS, HEAD_DIM)
    a = forgetting_attention(q.reshape(shp), k.reshape(shp), v.reshape(shp),
                             f_logit, b_f, q_gain, k_gain)
    pm = multiscale_pool(zp, pool_w, pool_scale)
    return jnp.concatenate([a, pm], axis=-1) @ w_out


def odd_mixer(h, w_in, conv_w, sgu_norm, sgu_w, sgu_b, w_out):
    p = h @ w_in
    v, gate_b, gate_c, zs = jnp.split(p, [CONV_WIDTH, 2 * CONV_WIDTH, 3 * CONV_WIDTH], axis=-1)
    c_out = short_gated_conv(v, gate_b, gate_c, conv_w)
    d_out = spatial_gating(zs, sgu_norm, sgu_w, sgu_b)
    return jnp.concatenate([c_out, d_out], axis=-1) @ w_out


def conv_glu_ffn(h, w_up, conv_w, w_down):
    g, u = jnp.split(h @ w_up, 2, axis=-1)
    g = causal_dwconv(g, conv_w)
    return (jax.nn.silu(g) * u) @ w_down


def setup_inputs(seed: int = 0) -> dict:
    key = jax.random.key(seed)
    ks = jax.random.split(key, 24)
    f32 = jnp.float32

    def nrm(k, shape, scale):
        return jax.random.normal(k, shape, f32) * scale

    def gain(k, n):
        return 1.0 + 0.05 * jax.random.normal(k, (n,), f32)

    return {
        'x': jax.random.normal(ks[0], (BATCH, SEQ, D_MODEL), f32),
        'l0_mix_norm': gain(ks[1], D_MODEL),
        'l0_w_in': nrm(ks[2], (D_MODEL, EVEN_IN), D_MODEL ** -0.5),
        'l0_b_f': FORGET_BIAS + 0.5 * jax.random.normal(ks[3], (N_ATTN_HEADS,), f32),
        'l0_q_gain': gain(ks[4], HEAD_DIM),
        'l0_k_gain': gain(ks[5], HEAD_DIM),
        'l0_pool_w': nrm(ks[6], (POOL_GROUPS, POOL_GROUP_DIM, POOL_GROUP_DIM), POOL_GROUP_DIM ** -0.5),
        'l0_pool_scale': 1.0 + 0.1 * jax.random.normal(ks[7], (MIX_HALF,), f32),
        'l0_w_out': nrm(ks[8], (2 * MIX_HALF, D_MODEL), (2 * MIX_HALF) ** -0.5),
        'l0_ffn_norm': gain(ks[9], D_MODEL),
        'l0_ffn_w_up': nrm(ks[10], (D_MODEL, 2 * D_FF), D_MODEL ** -0.5),
        'l0_ffn_conv': nrm(ks[11], (FFN_CONV_K, D_FF), FFN_CONV_K ** -0.5),
        'l0_ffn_w_down': nrm(ks[12], (D_FF, D_MODEL), D_FF ** -0.5),
        'l1_mix_norm': gain(ks[13], D_MODEL),
        'l1_w_in': nrm(ks[14], (D_MODEL, ODD_IN), D_MODEL ** -0.5),
        'l1_conv_w': nrm(ks[15], (CONV_K, CONV_WIDTH), CONV_K ** -0.5),
        'l1_sgu_norm': gain(ks[16], SGU_WIDTH),
        'l1_sgu_w': nrm(ks[17], (SGU_HEADS, SGU_CHUNK, SGU_CHUNK), SGU_CHUNK ** -0.5),
        'l1_sgu_b': 1.0 + 0.1 * jax.random.normal(ks[18], (SGU_HEADS, SGU_CHUNK), f32),
        'l1_w_out': nrm(ks[19], (CONV_WIDTH + SGU_WIDTH, D_MODEL), (CONV_WIDTH + SGU_WIDTH) ** -0.5),
        'l1_ffn_norm': gain(ks[20], D_MODEL),
        'l1_ffn_w_up': nrm(ks[21], (D_MODEL, 2 * D_FF), D_MODEL ** -0.5),
        'l1_ffn_conv': nrm(ks[22], (FFN_CONV_K, D_FF), FFN_CONV_K ** -0.5),
        'l1_ffn_w_down': nrm(ks[23], (D_FF, D_MODEL), D_FF ** -0.5),
    }


def reference(x, l0_mix_norm, l0_w_in, l0_b_f, l0_q_gain, l0_k_gain, l0_pool_w,
              l0_pool_scale, l0_w_out, l0_ffn_norm, l0_ffn_w_up, l0_ffn_conv, l0_ffn_w_down,
              l1_mix_norm, l1_w_in, l1_conv_w, l1_sgu_norm, l1_sgu_w, l1_sgu_b, l1_w_out,
              l1_ffn_norm, l1_ffn_w_up, l1_ffn_conv, l1_ffn_w_down):
    mix_norms = (l0_mix_norm, l1_mix_norm)
    even_params = (l0_w_in, l0_b_f, l0_q_gain, l0_k_gain, l0_pool_w, l0_pool_scale, l0_w_out)
    odd_params = (l1_w_in, l1_conv_w, l1_sgu_norm, l1_sgu_w, l1_sgu_b, l1_w_out)
    ffn_params = ((l0_ffn_norm, l0_ffn_w_up, l0_ffn_conv, l0_ffn_w_down),
                  (l1_ffn_norm, l1_ffn_w_up, l1_ffn_conv, l1_ffn_w_down))
    for layer in range(DEPTH):
        h = rmsnorm(x, mix_norms[layer])
        if layer % 2 == 0:
            x = x + even_mixer(h, *even_params)
        else:
            x = x + odd_mixer(h, *odd_params)
        f_norm, f_up, f_conv, f_down = ffn_params[layer]
        x = x + conv_glu_ffn(rmsnorm(x, f_norm), f_up, f_conv, f_down)
    return x
```

```cpp
#include <hip/hip_runtime.h>
#include <cstdio>
#include <cstdint>

namespace nv {
typedef short bf16x8 __attribute__((ext_vector_type(8)));
typedef float f32x4 __attribute__((ext_vector_type(4)));
constexpr int SEQ = 8192, DM = 4096, HALFW = 2048, NH = 16, HD = 128, DFF = 11008;
constexpr int EVEN_IN = 8208, ODD_IN = 10240;
constexpr float EPS = 1e-6f;

__device__ __forceinline__ unsigned short f2bf(float f) { unsigned u = __builtin_bit_cast(unsigned, f); return (unsigned short)((u + 0x7fffu + ((u >> 16) & 1u)) >> 16); }
__device__ __forceinline__ float block_sum_256(float v, float* sh) {
    for (int o = 32; o > 0; o >>= 1) v += __shfl_xor(v, o);
    __syncthreads();
    if ((threadIdx.x & 63) == 0) sh[threadIdx.x >> 6] = v;
    __syncthreads();
    return sh[0] + sh[1] + sh[2] + sh[3];
}

__global__ void __launch_bounds__(256) k_rmsnorm(const float* x, int ldx, const float* g, float* out, int ldo, int D) {
    __shared__ float sh[4];
    const float* xr = x + (size_t)blockIdx.x * ldx; float* o = out + (size_t)blockIdx.x * ldo;
    float s = 0.f;
    for (int c = threadIdx.x; c < D; c += 256) { const float v = xr[c]; s += v * v; }
    s = block_sum_256(s, sh);
    const float r = rsqrtf(s / (float)D + EPS);
    for (int c = threadIdx.x; c < D; c += 256) o[c] = xr[c] * r * g[c];
}

__global__ void __launch_bounds__(256) k_gemm(const float* A, int lda, const float* B, int ldb, float* C, int ldc, const float* R, int ldr, int M, int N, int K) {
    __shared__ unsigned short sA[128][40];
    __shared__ unsigned short sB[128][40];
    const int tid = threadIdx.x, lane = tid & 63, wid = tid >> 6, wm = wid >> 1, wn = wid & 1;
    const int m0 = blockIdx.y * 128, n0 = blockIdx.x * 128;
    f32x4 acc[4][4];
    for (int i = 0; i < 4; ++i) for (int j = 0; j < 4; ++j) acc[i][j] = (f32x4){0.f, 0.f, 0.f, 0.f};
    for (int k0 = 0; k0 < K; k0 += 32) {
        { const int r = tid >> 1, kc = (tid & 1) * 16; const float* p = A + (size_t)(m0 + r) * lda + k0 + kc;
          for (int j = 0; j < 16; ++j) sA[r][kc + j] = f2bf(p[j]); }
        { const int k = tid >> 3, nc = (tid & 7) * 16; const float* p = B + (size_t)(k0 + k) * ldb + n0 + nc;
          for (int j = 0; j < 16; ++j) sB[nc + j][k] = (n0 + nc + j < N) ? f2bf(p[j]) : (unsigned short)0; }
        __syncthreads();
        bf16x8 a[4], b[4];
        const int fr = lane & 15, fq = lane >> 4;
        for (int i = 0; i < 4; ++i) a[i] = *(const bf16x8*)&sA[wm * 64 + i * 16 + fr][fq * 8];
        for (int j = 0; j < 4; ++j) b[j] = *(const bf16x8*)&sB[wn * 64 + j * 16 + fr][fq * 8];
        for (int i = 0; i < 4; ++i) for (int j = 0; j < 4; ++j) acc[i][j] = __builtin_amdgcn_mfma_f32_16x16x32_bf16(a[i], b[j], acc[i][j], 0, 0, 0);
        __syncthreads();
    }
    const int cc = lane & 15, rq = lane >> 4;
    for (int i = 0; i < 4; ++i) for (int j = 0; j < 4; ++j) for (int e = 0; e < 4; ++e) {
        const int r = m0 + wm * 64 + i * 16 + rq * 4 + e, c = n0 + wn * 64 + j * 16 + cc;
        if (c < N) { float v = acc[i][j][e]; if (R) v += R[(size_t)r * ldr + c]; C[(size_t)r * ldc + c] = v; }
    }
}

__global__ void __launch_bounds__(256) k_headnorm(float* P, int ldp, const float* qg, const float* kg) {
    float* row = P + (size_t)blockIdx.x * ldp;
    const int lane = threadIdx.x & 63, w = threadIdx.x >> 6;
    for (int hh = w; hh < 2 * NH; hh += 4) {
        float* p = row + (hh < NH ? hh * HD : HALFW + (hh - NH) * HD); const float* g = hh < NH ? qg : kg;
        const float a = p[lane], b = p[lane + 64]; float s = a * a + b * b;
        for (int o = 32; o > 0; o >>= 1) s += __shfl_xor(s, o);
        const float r = rsqrtf(s / (float)HD + EPS);
        p[lane] = a * r * g[lane]; p[lane + 64] = b * r * g[lane + 64];
    }
}
__global__ void k_forget_cumsum(const float* P, int ldp, const float* bf, float* F, int S) {
    const int h = threadIdx.x; if (h >= NH) return;
    float c = 0.f;
    for (int t = 0; t < S; ++t) { const float x = P[(size_t)t * ldp + 3 * HALFW + h] + bf[h]; const float ls = fminf(x, 0.f) - log1pf(expf(-fabsf(x))); c += ls; F[(size_t)h * S + t] = c; }
}
__global__ void __launch_bounds__(256) k_fox_attn(const float* P, int ldp, const float* F, float* O, int ldo, int S) {
    __shared__ float qs[4][HD];
    const int lane = threadIdx.x & 63, w = threadIdx.x >> 6, t = blockIdx.x * 4 + w, h = blockIdx.y;
    const float* qrow = P + (size_t)t * ldp + h * HD;
    qs[w][lane] = qrow[lane]; qs[w][lane + 64] = qrow[lane + 64];
    __syncthreads();
    const float scale = 0.08838834764831845f; const float Ft = F[(size_t)h * S + t];
    float m = -1e30f, l = 0.f, o0 = 0.f, o1 = 0.f;
    for (int s0 = 0; s0 <= t; s0 += 64) {
        const int s = s0 + lane; float logit = -1e30f;
        if (s <= t) { const float* kr = P + (size_t)s * ldp + HALFW + h * HD; float d = 0.f;
            for (int i = 0; i < HD; i += 4) { const f32x4 kv = *(const f32x4*)(kr + i); d += kv[0] * qs[w][i] + kv[1] * qs[w][i + 1] + kv[2] * qs[w][i + 2] + kv[3] * qs[w][i + 3]; }
            logit = d * scale + (Ft - F[(size_t)h * S + s]); }
        float mx = logit; for (int o = 32; o > 0; o >>= 1) mx = fmaxf(mx, __shfl_xor(mx, o));
        const float mn = fmaxf(m, mx), alpha = expf(m - mn); m = mn;
        const float p = (s <= t) ? expf(logit - mn) : 0.f; float ps = p; for (int o = 32; o > 0; o >>= 1) ps += __shfl_xor(ps, o);
        l = l * alpha + ps; o0 *= alpha; o1 *= alpha;
        const int nk = (t - s0 + 1) < 64 ? (t - s0 + 1) : 64;
        for (int j = 0; j < nk; ++j) { const float pj = __shfl(p, j); const float* vr = P + (size_t)(s0 + j) * ldp + 2 * HALFW + h * HD; o0 += pj * vr[lane]; o1 += pj * vr[lane + 64]; }
    }
    O[(size_t)t * ldo + h * HD + lane] = o0 / l; O[(size_t)t * ldo + h * HD + lane + 64] = o1 / l;
}
__global__ void __launch_bounds__(256) k_pool_in(const float* P, int ldp, float* out, int ldo) {
    const int t = blockIdx.x;
    for (int c = threadIdx.x; c < HALFW; c += 256) { const int w = 2 << (c >> 9); const float* z = P + 3 * HALFW + NH + c;
        float s = 0.f; const int lo = t - w + 1 > 0 ? t - w + 1 : 0;
        for (int i = lo; i <= t; ++i) s += z[(size_t)i * ldp];
        const float cnt = (float)((t + 1) < w ? (t + 1) : w);
        out[(size_t)t * ldo + c] = s / cnt - z[(size_t)t * ldp]; }
}
__global__ void __launch_bounds__(256) k_colscale(float* X, int ldx, const float* s, int ncol) {
    float* r = X + (size_t)blockIdx.x * ldx; for (int c = threadIdx.x; c < ncol; c += 256) r[c] *= s[c];
}
__global__ void __launch_bounds__(256) k_gconv(const float* P, int ldp, const float* cw, float* out, int ldo) {
    const int t = blockIdx.x;
    for (int c = threadIdx.x; c < HALFW; c += 256) { float y = 0.f;
        for (int i = 0; i < 3; ++i) { const int tt = t - 2 + i; if (tt >= 0) { const float* pr = P + (size_t)tt * ldp; y += cw[i * HALFW + c] * (pr[2 * HALFW + c] * pr[c]); } }
        out[(size_t)t * ldo + c] = P[(size_t)t * ldp + HALFW + c] * y; }
}
__global__ void __launch_bounds__(256) k_gelu(float* P, int ldp, int c0, int n) {
    float* r = P + (size_t)blockIdx.x * ldp + c0; for (int c = threadIdx.x; c < n; c += 256) { const float v = r[c]; r[c] = 0.5f * v * (1.f + erff(v * 0.70710678118654752f)); }
}
__global__ void __launch_bounds__(256) k_sgu_mix(const float* P, int ldp, const float* sw, const float* sb, float* out, int ldo) {
    const int t = blockIdx.x, n = t >> 7, tl = t & 127;
    for (int c = threadIdx.x; c < HALFW; c += 256) { const int h = c >> 7; float a = 0.f;
        for (int s = 0; s <= tl; ++s) a += sw[((size_t)h * 128 + tl) * 128 + s] * P[(size_t)(n * 128 + s) * ldp + 4 * HALFW + c];
        out[(size_t)t * ldo + c] = P[(size_t)t * ldp + 3 * HALFW + c] * (a + sb[h * 128 + tl]); }
}
__global__ void __launch_bounds__(256) k_ffn_act(const float* GU, int ld, const float* cw, float* act, int lda) {
    const int t = blockIdx.x;
    for (int c = threadIdx.x; c < DFF; c += 256) { float y = 0.f;
        for (int i = 0; i < 3; ++i) { const int tt = t - 2 + i; if (tt >= 0) y += cw[i * DFF + c] * GU[(size_t)tt * ld + c]; }
        act[(size_t)t * lda + c] = y / (1.f + expf(-y)) * GU[(size_t)t * ld + DFF + c]; }
}

struct In { const float *x, *l0_mix_norm, *l0_w_in, *l0_b_f, *l0_q_gain, *l0_k_gain, *l0_pool_w, *l0_pool_scale, *l0_w_out, *l0_ffn_norm, *l0_ffn_w_up, *l0_ffn_conv, *l0_ffn_w_down,
                  *l1_mix_norm, *l1_w_in, *l1_conv_w, *l1_sgu_norm, *l1_sgu_w, *l1_sgu_b, *l1_w_out, *l1_ffn_norm, *l1_ffn_w_up, *l1_ffn_conv, *l1_ffn_w_down; };

static void gemm(hipStream_t st, const float* A, int lda, const float* B, int ldb, float* C, int ldc, const float* R, int ldr, int M, int N, int K) {
    k_gemm<<<dim3((N + 127) / 128, M / 128), 256, 0, st>>>(A, lda, B, ldb, C, ldc, R, ldr, M, N, K);
}
static void forward(hipStream_t st, const In& in, float* X, unsigned char* ws, int S) {
    const size_t MiB = 1u << 20;
    float* H = (float*)ws;
    float* R0 = (float*)(ws + 128 * MiB);
    float* P = R0;
    float* CC = (float*)((unsigned char*)R0 + 320 * MiB);
    float* PL = (float*)((unsigned char*)R0 + 448 * MiB);
    float* Fc = (float*)((unsigned char*)R0 + 512 * MiB);
    float* GU = R0;
    float* ACT = (float*)(ws + (128 + 688) * MiB);
    for (int layer = 0; layer < 2; ++layer) {
        k_rmsnorm<<<S, 256, 0, st>>>(X, DM, layer ? in.l1_mix_norm : in.l0_mix_norm, H, DM, DM);
        if (layer == 0) {
            gemm(st, H, DM, in.l0_w_in, EVEN_IN, P, EVEN_IN, nullptr, 0, S, EVEN_IN, DM);
            k_headnorm<<<S, 256, 0, st>>>(P, EVEN_IN, in.l0_q_gain, in.l0_k_gain);
            k_forget_cumsum<<<1, 64, 0, st>>>(P, EVEN_IN, in.l0_b_f, Fc, S);
            k_fox_attn<<<dim3(S / 4, NH), 256, 0, st>>>(P, EVEN_IN, Fc, CC, DM, S);
            k_pool_in<<<S, 256, 0, st>>>(P, EVEN_IN, PL, HALFW);
            for (int g = 0; g < 4; ++g) gemm(st, PL + g * 512, HALFW, in.l0_pool_w + (size_t)g * 512 * 512, 512, CC + HALFW + g * 512, DM, nullptr, 0, S, 512, 512);
            k_colscale<<<S, 256, 0, st>>>(CC + HALFW, DM, in.l0_pool_scale, HALFW);
            gemm(st, CC, DM, in.l0_w_out, DM, X, DM, X, DM, S, DM, DM);
        } else {
            gemm(st, H, DM, in.l1_w_in, ODD_IN, P, ODD_IN, nullptr, 0, S, ODD_IN, DM);
            k_gconv<<<S, 256, 0, st>>>(P, ODD_IN, in.l1_conv_w, CC, DM);
            k_gelu<<<S, 256, 0, st>>>(P, ODD_IN, 3 * HALFW, 2 * HALFW);
            k_rmsnorm<<<S, 256, 0, st>>>(P + 4 * HALFW, ODD_IN, in.l1_sgu_norm, P + 4 * HALFW, ODD_IN, HALFW);
            k_sgu_mix<<<S, 256, 0, st>>>(P, ODD_IN, in.l1_sgu_w, in.l1_sgu_b, CC + HALFW, DM);
            gemm(st, CC, DM, in.l1_w_out, DM, X, DM, X, DM, S, DM, DM);
        }
        k_rmsnorm<<<S, 256, 0, st>>>(X, DM, layer ? in.l1_ffn_norm : in.l0_ffn_norm, H, DM, DM);
        gemm(st, H, DM, layer ? in.l1_ffn_w_up : in.l0_ffn_w_up, 2 * DFF, GU, 2 * DFF, nullptr, 0, S, 2 * DFF, DM);
        k_ffn_act<<<S, 256, 0, st>>>(GU, 2 * DFF, layer ? in.l1_ffn_conv : in.l0_ffn_conv, ACT, DFF);
        gemm(st, ACT, DFF, layer ? in.l1_ffn_w_down : in.l0_ffn_w_down, DM, X, DM, X, DM, S, DM, DFF);
    }
}
}

extern "C" void kernel_launch(void* const* d_in, const int* in_sizes, int n_in, void* d_out, int out_size, void* d_ws, size_t ws_size, hipStream_t stream) {
    if (n_in != 24 || out_size != nv::SEQ * nv::DM || ws_size < (size_t)1160 * (1u << 20)) { fprintf(stderr, "kernel_launch: unexpected shapes (n_in %d out %d ws %zu)\n", n_in, out_size, ws_size); return; }
    nv::In in; const float** pp = (const float**)&in; for (int i = 0; i < 24; ++i) pp[i] = (const float*)d_in[i];
    hipMemcpyAsync(d_out, d_in[0], (size_t)out_size * 4, hipMemcpyDeviceToDevice, stream);
    nv::forward(stream, in, (float*)d_out, (unsigned char*)d_ws, nv::SEQ);
}
```

```cpp
#define MK_N_LAUNCHES 1
#include <hip/hip_runtime.h>
#include <cstdio>
#include <cstdint>
namespace pg8 {
#define PG8_LAS __attribute__((address_space(3)))
typedef unsigned short bf16_t;
typedef short bf16x8 __attribute__((ext_vector_type(8)));
typedef float f32x4 __attribute__((ext_vector_type(4)));
typedef unsigned u32x4 __attribute__((ext_vector_type(4)));
constexpr int BM = 256, BK = 64, HALF = 128, HTB = HALF * BK * 2  , STAGE_BYTES = 8 * HTB, NXCD = 8, WGM = 8;

__host__ __device__ __forceinline__ int lds_byte(int r, int c) { const int st = (r >> 4) * 2 + (c >> 5), rr = r & 15, cc = c & 31, ob = rr * 64 + cc * 2; return st * 1024 + (ob ^ (((ob >> 9) & 1) << 5)); }
__host__ __device__ __forceinline__ void stage_rc(int b, int& R, int& C) { const int st = b / 1024, sb = b % 1024, swz = sb ^ (((sb >> 9) & 1) << 5); R = (st >> 1) * 16 + swz / 64; C = (st & 1) * 32 + (swz % 64) / 2; }
__host__ __device__ __forceinline__ int perm32(int rho) { const int n = rho >> 4, i = rho & 15; return 8 * (i >> 2) + 4 * n + (i & 3); }

struct Unit { int pm, pn; };
struct Gemm { const bf16_t* A; const bf16_t* Bt; int M, N, K; };

struct StaticOrder {
    int nM, nN, nwg, G, c;
    __host__ __device__ __forceinline__ void init(int M, int N, int G_, int c_) { nM = M / BM; nN = N / BM; nwg = nM * nN; G = G_; c = c_; }
    __host__ __device__ __forceinline__ bool next(int i, Unit& u) const {
        const long L = (long)i * G + c; if (L >= nwg) return false;
        int wgid = (int)L; { const int q = nwg / NXCD, r = nwg % NXCD, xcd = wgid % NXCD, off = wgid / NXCD; wgid = (xcd < r ? xcd * (q + 1) : r * (q + 1) + (xcd - r) * q) + off; }
        const int nig = WGM * nN, gid = wgid / nig, fm = gid * WGM, gsz = (nM - fm) < WGM ? (nM - fm) : WGM;
        u.pm = fm + ((wgid % nig) % gsz); u.pn = (wgid % nig) / gsz; return true;
    }
    __device__ __forceinline__ void a_ready(const Unit&) const {}
    __device__ __forceinline__ void done(const Unit&) const {}
};

typedef float cvt_pk_bf16_f2 __attribute__((ext_vector_type(2))); typedef __bf16 cvt_pk_bf16_b2 __attribute__((ext_vector_type(2)));
__device__ __forceinline__ unsigned cvt_pk_bf16(float lo, float hi) { const cvt_pk_bf16_f2 v = {lo, hi}; return __builtin_bit_cast(unsigned, __builtin_convertvector(v, cvt_pk_bf16_b2)); }
typedef float f32x2 __attribute__((ext_vector_type(2)));
__device__ __forceinline__ f32x2 gelu_pk(f32x2 v) {
    const f32x2 av = __builtin_elementwise_abs(v), d = av * 0.2316418882f + 1.0f;
    f32x2 t; t.x = __builtin_amdgcn_rcpf(d.x); t.y = __builtin_amdgcn_rcpf(d.y);
    f32x2 q = t * 0.5307027145f + (-0.7265760135f); q = q * t + 0.7107068705f; q = q * t + (-0.142248368f); q = q * t + 0.127414796f; q = q * t;
    const f32x2 s = (v * v) * (-0.72134752044f);
    f32x2 e; e.x = __builtin_amdgcn_exp2f(s.x); e.y = __builtin_amdgcn_exp2f(s.y);
    const f32x2 m = v * (q * e), r = v - m;
    f32x2 o; o.x = v.x < 0.f ? m.x : r.x; o.y = v.y < 0.f ? m.y : r.y; return o;
}

template <int ACT  > struct EpiBf16 {
    static constexpr bool PERM = true, AFTER_DRAIN = false; static_assert(ACT == 0 || ACT == 1, "EpiBf16: ACT is 0 (none) or 1 (gelu_pk)");
    bf16_t* O; int ldc; const float* bias; int split_cols; size_t split_stride; float scale0;
    __device__ __forceinline__ void operator()(const f32x4 (&acc)[2][2][4][2], const Unit& u, int wr, int wc, int fr, int fq) const {
        const int row0 = u.pm * BM + wr * 64 + fr; int colt = u.pn * BM; bf16_t* base = O;
        float sc = 1.f; if (split_cols) { const int t = colt / split_cols; base += (size_t)t * split_stride; colt -= t * split_cols; if (t == 0) sc = scale0; }
        const int col0 = colt + wc * 32 + 8 * fq, bcol0 = u.pn * BM + wc * 32 + 8 * fq;
        f32x4 bv[2][2];
#pragma unroll
        for (int bj = 0; bj < 2; ++bj)
#pragma unroll
            for (int n = 0; n < 2; ++n) bv[bj][n] = bias ? *(const f32x4*)(bias + bcol0 + bj * HALF + 4 * n) : (f32x4){0.f, 0.f, 0.f, 0.f};
#pragma unroll
        for (int ai = 0; ai < 2; ++ai)
#pragma unroll
            for (int m = 0; m < 4; ++m) { bf16_t* rowp = base + (size_t)(row0 + ai * HALF + m * 16) * ldc + col0;
#pragma unroll
                for (int bj = 0; bj < 2; ++bj) { f32x4 v0 = acc[ai][bj][m][0] + bv[bj][0], v1 = acc[ai][bj][m][1] + bv[bj][1];
                    if (ACT == 1) { f32x2 a = gelu_pk((f32x2){v0[0], v0[1]}), b = gelu_pk((f32x2){v0[2], v0[3]}), c = gelu_pk((f32x2){v1[0], v1[1]}), d = gelu_pk((f32x2){v1[2], v1[3]});
                        v0 = (f32x4){a.x, a.y, b.x, b.y}; v1 = (f32x4){c.x, c.y, d.x, d.y}; }
                    v0 = v0 * sc; v1 = v1 * sc; u32x4 w; w.x = cvt_pk_bf16(v0[0], v0[1]); w.y = cvt_pk_bf16(v0[2], v0[3]); w.z = cvt_pk_bf16(v1[0], v1[1]); w.w = cvt_pk_bf16(v1[2], v1[3]);
                    *(u32x4*)(rowp + bj * HALF) = w; } }
    }
};
template <class Epi, class Sched, bool ALIGN_EPI = false, bool SP2 = false>
__device__ __forceinline__ void gemm_phase(PG8_LAS unsigned char* lds, const Gemm g, const Sched& S, const Epi& E) {
    const int tid = threadIdx.x, wid = __builtin_amdgcn_readfirstlane(tid >> 6), lane = tid & 63, wr = wid >> 2, wc = wid & 3, fr = lane & 15, fq = lane >> 4;
    const int K = g.K, nt = K / BK;
    unsigned voffA[2], voffB[2];
#pragma unroll
    for (int i = 0; i < 2; ++i) { int R, C; stage_rc(tid * 16 + i * 8192, R, C); const int Rb = Epi::PERM ? ((R & ~31) + perm32(R & 31)) : R;
        voffA[i] = (unsigned)(R * K + C) * 2u; voffB[i] = (unsigned)(Rb * K + C) * 2u; }
    const size_t kstep = (size_t)(BK * 2);
    const size_t hstep = (size_t)HALF * K * 2;
    const size_t tstep = 2 * hstep;
    const unsigned ldsw = (unsigned)wid * 1024u;
    const int aoff = lds_byte(wr * 64 + fr, fq * 8), boff = lds_byte(wc * 32 + fr, fq * 8);
#define PG8_SA(b, h) (((b) * 2 + (h)) * HTB)
#define PG8_SB(b, h) ((4 + (b) * 2 + (h)) * HTB)
#define PG8_STAGE(bufoff, gbase, voff) do { _Pragma("unroll") for (int _i = 0; _i < 2; ++_i) \
        __builtin_amdgcn_global_load_lds((const unsigned*)((const char*)(gbase) + (voff)[_i]), (PG8_LAS unsigned*)(lds + (bufoff) + ldsw + _i * 8192), 16, 0, 0); } while (0)
#define PG8_LDA(dst, b, h) do { _Pragma("unroll") for (int m = 0; m < 4; ++m) _Pragma("unroll") for (int k = 0; k < 2; ++k) dst[m][k] = *(const PG8_LAS bf16x8*)(lds + PG8_SA(b, h) + aoff + m * 2048 + k * 1024); } while (0)
#define PG8_LDB(dst, b, h) do { _Pragma("unroll") for (int n = 0; n < 2; ++n) _Pragma("unroll") for (int k = 0; k < 2; ++k) dst[n][k] = *(const PG8_LAS bf16x8*)(lds + PG8_SB(b, h) + boff + n * 2048 + k * 1024); } while (0)
#define PG8_MMA(ai, bj, At, Bt) do { __builtin_amdgcn_s_setprio(1); _Pragma("unroll") for (int m = 0; m < 4; ++m) _Pragma("unroll") for (int n = 0; n < 2; ++n) _Pragma("unroll") for (int k = 0; k < 2; ++k) \
        acc[ai][bj][m][n] = __builtin_amdgcn_mfma_f32_16x16x32_bf16(Bt[n][k], At[m][k], acc[ai][bj][m][n], 0, 0, 0); __builtin_amdgcn_s_setprio(0); } while (0)
#define PG8_WAIT_V(n) asm volatile("s_waitcnt vmcnt(" #n ")" ::: "memory")
#define PG8_WAIT_L(n) asm volatile("s_waitcnt lgkmcnt(" #n ")" ::: "memory")
#define PG8_BAR __builtin_amdgcn_s_barrier()
#define PG8_SCHED __builtin_amdgcn_sched_barrier(0)
    Unit cur, nxt; int ui = 0;
    if (!S.next(0, cur)) return;
    f32x4 acc[2][2][4][2];
#pragma unroll
    for (int a = 0; a < 2; ++a)
#pragma unroll
        for (int b = 0; b < 2; ++b)
#pragma unroll
            for (int m = 0; m < 4; ++m)
#pragma unroll
                for (int n = 0; n < 2; ++n) acc[a][b][m][n] = (f32x4){0.f, 0.f, 0.f, 0.f};
    bf16x8 At[4][2], B0[2][2], B1[2][2];
    const char* cA = (const char*)g.A + (size_t)cur.pm * tstep; const char* cB = (const char*)g.Bt + (size_t)cur.pn * tstep;
    S.a_ready(cur);
    if constexpr (SP2) {
        PG8_STAGE(PG8_SB(0, 0), cB, voffB); PG8_STAGE(PG8_SB(0, 1), cB + hstep, voffB); PG8_STAGE(PG8_SA(0, 0), cA, voffA); PG8_STAGE(PG8_SA(0, 1), cA + hstep, voffA);
        if (wr == 1) PG8_BAR;
        PG8_WAIT_V(2); PG8_BAR;
        PG8_STAGE(PG8_SB(1, 0), cB + kstep, voffB); PG8_STAGE(PG8_SA(1, 0), cA + kstep, voffA); PG8_STAGE(PG8_SB(1, 1), cB + hstep + kstep, voffB);
        PG8_WAIT_V(6); PG8_BAR;
    } else {
        PG8_STAGE(PG8_SB(0, 0), cB, voffB); PG8_STAGE(PG8_SA(0, 0), cA, voffA); PG8_STAGE(PG8_SB(0, 1), cB + hstep, voffB); PG8_STAGE(PG8_SA(0, 1), cA + hstep, voffA);
        if (wr == 1) PG8_BAR;
        PG8_WAIT_V(4); PG8_BAR;
        PG8_STAGE(PG8_SB(1, 0), cB + kstep, voffB); PG8_STAGE(PG8_SA(1, 0), cA + kstep, voffA); PG8_STAGE(PG8_SB(1, 1), cB + hstep + kstep, voffB);
        PG8_WAIT_V(6); PG8_BAR;
    }
    for (;;) {
        const bool has_next = S.next(ui + 1, nxt);
        const char* nA = has_next ? (const char*)g.A + (size_t)nxt.pm * tstep : cA; const char* nB = has_next ? (const char*)g.Bt + (size_t)nxt.pn * tstep : cB;
        for (int t = 0; t < nt; t += 2) {
            const bool last = (t == nt - 2);
            const char* a1 = cA + (size_t)(t + 1) * kstep;
            const char* a2 = last ? nA : cA + (size_t)(t + 2) * kstep; const char* b2 = last ? nB : cB + (size_t)(t + 2) * kstep;
            const char* a3 = a2 + kstep; const char* b3 = b2 + kstep;
            if (last && has_next) S.a_ready(nxt);
            if constexpr (SP2) {
            PG8_LDB(B0, 0, 0); PG8_LDB(B1, 0, 1); PG8_SCHED; PG8_LDA(At, 0, 0); PG8_STAGE(PG8_SA(1, 1), a1 + hstep, voffA);
            PG8_WAIT_V(8); PG8_WAIT_L(0); PG8_BAR; PG8_MMA(0, 0, At, B0); PG8_MMA(0, 1, At, B1); PG8_BAR; PG8_SCHED;
            PG8_LDA(At, 0, 1); PG8_STAGE(PG8_SB(0, 0), b2, voffB); PG8_STAGE(PG8_SB(0, 1), b2 + hstep, voffB); PG8_STAGE(PG8_SA(0, 0), a2, voffA);
            PG8_WAIT_V(8); PG8_WAIT_L(0); PG8_BAR; PG8_MMA(1, 0, At, B0); PG8_MMA(1, 1, At, B1); PG8_BAR; PG8_SCHED;
            PG8_LDB(B0, 1, 0); PG8_LDB(B1, 1, 1); PG8_SCHED; PG8_LDA(At, 1, 0); PG8_STAGE(PG8_SA(0, 1), a2 + hstep, voffA);
            PG8_WAIT_V(8); PG8_WAIT_L(0); PG8_BAR; PG8_MMA(0, 0, At, B0); PG8_MMA(0, 1, At, B1); PG8_BAR; PG8_SCHED;
            PG8_LDA(At, 1, 1); PG8_STAGE(PG8_SB(1, 0), b3, voffB); PG8_STAGE(PG8_SB(1, 1), b3 + hstep, voffB); PG8_STAGE(PG8_SA(1, 0), a3, voffA);
            PG8_WAIT_V(8); PG8_WAIT_L(0); PG8_BAR; PG8_MMA(1, 0, At, B0); PG8_MMA(1, 1, At, B1); PG8_BAR; PG8_SCHED;
            } else {
            PG8_LDB(B0, 0, 0); PG8_SCHED; PG8_LDA(At, 0, 0); PG8_STAGE(PG8_SA(1, 1), a1 + hstep, voffA);
            PG8_WAIT_L(8); PG8_BAR; PG8_WAIT_L(0); PG8_MMA(0, 0, At, B0); PG8_BAR; PG8_SCHED;
            PG8_LDB(B1, 0, 1); PG8_STAGE(PG8_SB(0, 0), b2, voffB);
            PG8_BAR; PG8_WAIT_L(0); PG8_MMA(0, 1, At, B1); PG8_BAR;
            PG8_LDA(At, 0, 1); PG8_STAGE(PG8_SA(0, 0), a2, voffA);
            PG8_BAR; PG8_WAIT_L(0); PG8_MMA(1, 0, At, B0); PG8_BAR; PG8_SCHED;
            PG8_STAGE(PG8_SB(0, 1), b2 + hstep, voffB);
            PG8_WAIT_V(6); PG8_BAR; PG8_MMA(1, 1, At, B1); PG8_BAR;
            PG8_LDB(B0, 1, 0); PG8_SCHED; PG8_LDA(At, 1, 0); PG8_STAGE(PG8_SA(0, 1), a2 + hstep, voffA);
            PG8_WAIT_L(8); PG8_BAR; PG8_WAIT_L(0); PG8_MMA(0, 0, At, B0); PG8_BAR; PG8_SCHED;
            PG8_LDB(B1, 1, 1); PG8_STAGE(PG8_SB(1, 0), b3, voffB);
            PG8_BAR; PG8_WAIT_L(0); PG8_MMA(0, 1, At, B1); PG8_BAR;
            PG8_LDA(At, 1, 1); PG8_STAGE(PG8_SA(1, 0), a3, voffA);
            PG8_BAR; PG8_WAIT_L(0); PG8_MMA(1, 0, At, B0); PG8_BAR; PG8_SCHED;
            PG8_STAGE(PG8_SB(1, 1), b3 + hstep, voffB);
            PG8_WAIT_V(6); PG8_BAR; PG8_MMA(1, 1, At, B1); PG8_BAR;
            }
        }
        if constexpr (ALIGN_EPI) { if (wr == 0) PG8_BAR; }
        if constexpr (!Epi::AFTER_DRAIN) { E(acc, cur, wr, wc, fr, fq); S.done(cur); }
        if (!has_next) break;
#pragma unroll
        for (int a = 0; a < 2; ++a)
#pragma unroll
            for (int b = 0; b < 2; ++b)
#pragma unroll
                for (int m = 0; m < 4; ++m)
#pragma unroll
                    for (int n = 0; n < 2; ++n) acc[a][b][m][n] = (f32x4){0.f, 0.f, 0.f, 0.f};
        cur = nxt; cA = nA; cB = nB; ++ui;
        if constexpr (ALIGN_EPI) { if (wr == 1) PG8_BAR; }
    }
    PG8_WAIT_V(0);
    if constexpr (!ALIGN_EPI) { if (wr == 0) PG8_BAR; }
    PG8_BAR;
    if constexpr (Epi::AFTER_DRAIN) { E.fused(acc, cur, wr, wc, fr, fq, lds, wid, lane); S.done(cur); }
#undef PG8_SA
#undef PG8_SB
#undef PG8_STAGE
#undef PG8_LDA
#undef PG8_LDB
#undef PG8_MMA
#undef PG8_WAIT_V
#undef PG8_WAIT_L
#undef PG8_BAR
#undef PG8_SCHED
}

struct RowScale {
    const float* ssp; int nparts; PG8_LAS float* rr; mutable int last = -1;
    __device__ __forceinline__ bool need(int row0) const { return last != row0; }
    __device__ __forceinline__ void fill(int row0, int tid) const {
        last = row0;
        if (tid < 256) { float v[16];
#pragma unroll
            for (int p = 0; p < 16; ++p) v[p] = p < nparts ? ssp[(size_t)p * 8192 + row0 + tid] : 0.f;
            const float s = (((v[0] + v[1]) + (v[2] + v[3])) + ((v[4] + v[5]) + (v[6] + v[7]))) + (((v[8] + v[9]) + (v[10] + v[11])) + ((v[12] + v[13]) + (v[14] + v[15])));
            rr[tid] = 1.0f / sqrtf(s * (1.0f / 4096.0f) + 1e-6f); }
    }
    __device__ __forceinline__ void sync() const { asm volatile("s_waitcnt lgkmcnt(0)" ::: "memory"); __builtin_amdgcn_s_barrier(); asm volatile("" ::: "memory"); }
};
struct EpiQKVZ {
    static constexpr bool PERM = true, AFTER_DRAIN = false;
    bf16_t* QKV; bf16_t* ZP; RowScale rs; const float* qg; const float* kg; PG8_LAS float* hn;
    __device__ __forceinline__ void store(const f32x4 (&acc)[2][2][4][2], bf16_t* base0, size_t bjstep, int ld, const PG8_LAS float* rl) const {
#pragma unroll
        for (int ai = 0; ai < 2; ++ai)
#pragma unroll
            for (int m = 0; m < 4; ++m) { bf16_t* rowp = base0 + (size_t)(ai * HALF + m * 16) * ld; const float r = rl[ai * HALF + m * 16];
#pragma unroll
                for (int bj = 0; bj < 2; ++bj) { const f32x4 v0 = acc[ai][bj][m][0] * r, v1 = acc[ai][bj][m][1] * r;
                    u32x4 w; w.x = cvt_pk_bf16(v0[0], v0[1]); w.y = cvt_pk_bf16(v0[2], v0[3]); w.z = cvt_pk_bf16(v1[0], v1[1]); w.w = cvt_pk_bf16(v1[2], v1[3]);
                    *(u32x4*)(rowp + bj * bjstep) = w; } }
    }
    __device__ __forceinline__ void operator()(const f32x4 (&acc)[2][2][4][2], const Unit& u, int wr, int wc, int fr, int fq) const {
        const int row0 = u.pm * BM + wr * 64 + fr, cl = wc * 32 + 8 * fq;
        if (rs.need(u.pm * BM)) { rs.fill(u.pm * BM, (wr * 4 + wc) * 64 + fq * 16 + fr); rs.sync(); }
        const PG8_LAS float* rl = rs.rr + wr * 64 + fr;
        if (u.pn < 16) {
#pragma unroll
            for (int ai = 0; ai < 2; ++ai)
#pragma unroll
                for (int m = 0; m < 4; ++m) { const float r = rl[ai * HALF + m * 16];
#pragma unroll
                    for (int bj = 0; bj < 2; ++bj) { const f32x4 a0 = acc[ai][bj][m][0] * r, a1 = acc[ai][bj][m][1] * r;
                        float sq = ((a0[0] * a0[0] + a0[1] * a0[1]) + (a0[2] * a0[2] + a0[3] * a0[3])) + ((a1[0] * a1[0] + a1[1] * a1[1]) + (a1[2] * a1[2] + a1[3] * a1[3]));
                        sq += __shfl_xor(sq, 16); sq += __shfl_xor(sq, 32);
                        if (fq == 0) hn[((ai * HALF + wr * 64 + m * 16 + fr) * 2 + bj) * 4 + wc] = sq; } }
            asm volatile("s_waitcnt lgkmcnt(0)" ::: "memory"); __builtin_amdgcn_s_barrier(); asm volatile("" ::: "memory");
            const float* gp = (u.pn < 8 ? qg : kg) + cl; const f32x4 g0 = *(const f32x4*)gp, g1 = *(const f32x4*)(gp + 4);
            bf16_t* base0 = QKV + (size_t)(u.pn * 2) * 8192 * 128 + (size_t)row0 * 128 + cl;
#pragma unroll
            for (int ai = 0; ai < 2; ++ai)
#pragma unroll
                for (int m = 0; m < 4; ++m) { const int rw = ai * HALF + wr * 64 + m * 16 + fr; const float r = rl[ai * HALF + m * 16];
#pragma unroll
                    for (int bj = 0; bj < 2; ++bj) { const f32x4 p = *(const PG8_LAS f32x4*)(hn + (rw * 2 + bj) * 4);
                        const float sc = r * __builtin_amdgcn_rsqf(((p[0] + p[1]) + (p[2] + p[3])) * (1.0f / 128.0f) + 1e-6f);
                        const f32x4 v0 = acc[ai][bj][m][0] * sc * g0, v1 = acc[ai][bj][m][1] * sc * g1;
                        u32x4 w; w.x = cvt_pk_bf16(v0[0], v0[1]); w.y = cvt_pk_bf16(v0[2], v0[3]); w.z = cvt_pk_bf16(v1[0], v1[1]); w.w = cvt_pk_bf16(v1[2], v1[3]);
                        *(u32x4*)(base0 + (size_t)(ai * HALF + m * 16) * 128 + bj * ((size_t)8192 * 128)) = w; } }
        }
        else if (u.pn < 24) store(acc, QKV + (size_t)(u.pn * 2) * 8192 * 128 + (size_t)row0 * 128 + cl, (size_t)8192 * 128, 128, rl);
        else store(acc, ZP + (size_t)row0 * 2048 + (u.pn - 24) * 256 + cl, (size_t)128, 2048, rl);
    }
};
template <int MODE  > struct EpiBf16G {
    static constexpr bool PERM = true, AFTER_DRAIN = false;
    bf16_t* O; int ldc; RowScale rs;
    template <bool G> __device__ __forceinline__ void body(const f32x4 (&acc)[2][2][4][2], bf16_t* base, const PG8_LAS float* rl) const {
        f32x4 cs[2][2];
        if (MODE == 1) {
#pragma unroll
            for (int bj = 0; bj < 2; ++bj) { cs[bj][0] = *(const PG8_LAS f32x4*)(rl + bj * HALF); cs[bj][1] = *(const PG8_LAS f32x4*)(rl + bj * HALF + 4); } }
#pragma unroll
        for (int ai = 0; ai < 2; ++ai)
#pragma unroll
            for (int m = 0; m < 4; ++m) { bf16_t* rowp = base + (size_t)(ai * HALF + m * 16) * ldc; const float r = MODE == 1 ? 1.f : rl[ai * HALF + m * 16];
#pragma unroll
                for (int bj = 0; bj < 2; ++bj) { f32x4 v0, v1;
                    if (MODE == 1) { v0 = acc[ai][bj][m][0] * cs[bj][0]; v1 = acc[ai][bj][m][1] * cs[bj][1]; } else { v0 = acc[ai][bj][m][0] * r; v1 = acc[ai][bj][m][1] * r; }
                    if (G) { f32x2 a = gelu_pk((f32x2){v0[0], v0[1]}), b = gelu_pk((f32x2){v0[2], v0[3]}), c = gelu_pk((f32x2){v1[0], v1[1]}), d = gelu_pk((f32x2){v1[2], v1[3]});
                        v0 = (f32x4){a.x, a.y, b.x, b.y}; v1 = (f32x4){c.x, c.y, d.x, d.y}; }
                    u32x4 w; w.x = cvt_pk_bf16(v0[0], v0[1]); w.y = cvt_pk_bf16(v0[2], v0[3]); w.z = cvt_pk_bf16(v1[0], v1[1]); w.w = cvt_pk_bf16(v1[2], v1[3]);
                    *(u32x4*)(rowp + bj * HALF) = w; } }
    }
    __device__ __forceinline__ void operator()(const f32x4 (&acc)[2][2][4][2], const Unit& u, int wr, int wc, int fr, int fq) const {
        bf16_t* base = O + (size_t)(u.pm * BM + wr * 64 + fr) * ldc + u.pn * BM + wc * 32 + 8 * fq;
        if (rs.need((MODE == 1 ? u.pn : u.pm) * BM)) { rs.fill((MODE == 1 ? u.pn : u.pm) * BM, (wr * 4 + wc) * 64 + fq * 16 + fr); rs.sync(); }
        const PG8_LAS float* rl = MODE == 1 ? rs.rr + wc * 32 + 8 * fq : rs.rr + wr * 64 + fr;
        if (MODE == 1 || (MODE == 2 && u.pn >= 24)) body<true>(acc, base, rl); else body<false>(acc, base, rl);
    }
};
template <int MODE> struct EpiResB {
    static constexpr bool PERM = true, AFTER_DRAIN = false;
    const float* xin; float* out; bf16_t* XB; int ldc; float* ssp; PG8_LAS float* red;
    __device__ __forceinline__ void load2(f32x4 (&b)[2][2][2], size_t off0) const {
#pragma unroll
        for (int mm = 0; mm < 2; ++mm) { const size_t off = off0 + (size_t)(mm * 16) * ldc;
            if (MODE == 0) {
#pragma unroll
                for (int bj = 0; bj < 2; ++bj) { b[mm][bj][0] = *(const f32x4*)(xin + off + bj * HALF); b[mm][bj][1] = *(const f32x4*)(xin + off + bj * HALF + 4); }
            } else {
#pragma unroll
                for (int bj = 0; bj < 2; ++bj) { const u32x4 w = *(const u32x4*)(XB + off + bj * HALF);
                    b[mm][bj][0] = (f32x4){__builtin_bit_cast(float, w.x << 16), __builtin_bit_cast(float, w.x & 0xffff0000u), __builtin_bit_cast(float, w.y << 16), __builtin_bit_cast(float, w.y & 0xffff0000u)};
                    b[mm][bj][1] = (f32x4){__builtin_bit_cast(float, w.z << 16), __builtin_bit_cast(float, w.z & 0xffff0000u), __builtin_bit_cast(float, w.w << 16), __builtin_bit_cast(float, w.w & 0xffff0000u)}; }
            } }
    }
    __device__ __forceinline__ void operator()(const f32x4 (&acc)[2][2][4][2], const Unit& u, int wr, int wc, int fr, int fq) const {
        const int row0 = u.pm * BM + wr * 64 + fr, col0 = u.pn * BM + wc * 32 + 8 * fq;
        const size_t base = (size_t)row0 * ldc + col0;
        f32x4 bc[2][2][2], bn[2][2][2];
        load2(bc, base);
#pragma unroll
        for (int k = 0; k < 4; ++k) { const int ai = k >> 1, m0 = (k & 1) * 2;
            if (k < 3) load2(bn, base + (size_t)(((k + 1) >> 1) * HALF + ((k + 1) & 1) * 32) * ldc);
#pragma unroll
            for (int mm = 0; mm < 2; ++mm) { const int m = m0 + mm; const size_t off = base + (size_t)(ai * HALF + m * 16) * ldc; float s = 0.f;
#pragma unroll
                for (int bj = 0; bj < 2; ++bj) { const f32x4 v0 = bc[mm][bj][0] + acc[ai][bj][m][0], v1 = bc[mm][bj][1] + acc[ai][bj][m][1];
                    if (MODE == 2) { *(f32x4*)(out + off + bj * HALF) = v0; *(f32x4*)(out + off + bj * HALF + 4) = v1; }
                    else { s += ((v0[0] * v0[0] + v0[1] * v0[1]) + (v0[2] * v0[2] + v0[3] * v0[3])) + ((v1[0] * v1[0] + v1[1] * v1[1]) + (v1[2] * v1[2] + v1[3] * v1[3]));
                        u32x4 w; w.x = cvt_pk_bf16(v0[0], v0[1]); w.y = cvt_pk_bf16(v0[2], v0[3]); w.z = cvt_pk_bf16(v1[0], v1[1]); w.w = cvt_pk_bf16(v1[2], v1[3]);
                        *(u32x4*)(XB + off + bj * HALF) = w; } }
                if (MODE != 2) { s += __shfl_xor(s, 16); s += __shfl_xor(s, 32);
                    if (fq == 0) red[wc * 256 + ai * HALF + wr * 64 + m * 16 + fr] = s; } }
            if (k < 3) {
#pragma unroll
                for (int mm = 0; mm < 2; ++mm)
#pragma unroll
                    for (int bj = 0; bj < 2; ++bj) { bc[mm][bj][0] = bn[mm][bj][0]; bc[mm][bj][1] = bn[mm][bj][1]; } }
        }
        if (MODE != 2) {
            asm volatile("s_waitcnt lgkmcnt(0)" ::: "memory"); __builtin_amdgcn_s_barrier(); asm volatile("" ::: "memory");
            const int tid = (wr * 4 + wc) * 64 + fq * 16 + fr;
            if (tid < 256) ssp[(size_t)u.pn * 8192 + u.pm * BM + tid] = (red[tid] + red[256 + tid]) + (red[512 + tid] + red[768 + tid]);
        }
    }
};
struct EpiPool {
    static constexpr bool PERM = true, AFTER_DRAIN = false;
    bf16_t* O; int ldc; const float* scale;
    __device__ __forceinline__ void operator()(const f32x4 (&acc)[2][2][4][2], const Unit& u, int wr, int wc, int fr, int fq) const {
        const int row0 = (u.pm & 31) * BM + wr * 64 + fr, col0 = u.pn * BM + wc * 32 + 8 * fq;
#pragma unroll
        for (int bj = 0; bj < 2; ++bj) { const f32x4 s0 = *(const f32x4*)(scale + col0 + bj * HALF), s1 = *(const f32x4*)(scale + col0 + bj * HALF + 4);
#pragma unroll
            for (int ai = 0; ai < 2; ++ai)
#pragma unroll
                for (int m = 0; m < 4; ++m) { const f32x4 v0 = acc[ai][bj][m][0] * s0, v1 = acc[ai][bj][m][1] * s1;
                    u32x4 w; w.x = cvt_pk_bf16(v0[0], v0[1]); w.y = cvt_pk_bf16(v0[2], v0[3]); w.z = cvt_pk_bf16(v1[0], v1[1]); w.w = cvt_pk_bf16(v1[2], v1[3]);
                    *(u32x4*)(O + (size_t)(row0 + ai * HALF + m * 16) * ldc + 2048 + col0 + bj * HALF) = w; } }
    }
};
struct PoolOrder {
    int G, c;
    __device__ __forceinline__ bool next(int i, Unit& u) const { const int L = i * G + c; if (L >= 256) return false; const int g = L >> 6, r = L & 63; u.pm = 32 * g + (r >> 1); u.pn = 2 * g + (r & 1); return true; }
    __device__ __forceinline__ void a_ready(const Unit&) const {}
    __device__ __forceinline__ void done(const Unit&) const {}
};

__device__ __forceinline__ float dpp_shr1(float old, float src) { return __builtin_bit_cast(float, __builtin_amdgcn_update_dpp(__builtin_bit_cast(int, old), __builtin_bit_cast(int, src), 0x111, 0xF, 0xF, false)); }
__device__ __forceinline__ float dpp_shr2(float old, float src) { return __builtin_bit_cast(float, __builtin_amdgcn_update_dpp(__builtin_bit_cast(int, old), __builtin_bit_cast(int, src), 0x112, 0xF, 0xF, false)); }
__device__ __forceinline__ float dpp_ror1(float src) { return __builtin_bit_cast(float, __builtin_amdgcn_update_dpp(0, __builtin_bit_cast(int, src), 0x121, 0xF, 0xF, false)); }
__device__ __forceinline__ float dpp_ror2(float src) { return __builtin_bit_cast(float, __builtin_amdgcn_update_dpp(0, __builtin_bit_cast(int, src), 0x122, 0xF, 0xF, false)); }
__device__ __forceinline__ float dppz_shr1(float src) { return __builtin_bit_cast(float, __builtin_amdgcn_update_dpp(0, __builtin_bit_cast(int, src), 0x111, 0xF, 0xF, true)); }
__device__ __forceinline__ float dppz_shr2(float src) { return __builtin_bit_cast(float, __builtin_amdgcn_update_dpp(0, __builtin_bit_cast(int, src), 0x112, 0xF, 0xF, true)); }
__device__ __forceinline__ float dppz_ror1(float src) { return __builtin_bit_cast(float, __builtin_amdgcn_update_dpp(0, __builtin_bit_cast(int, src), 0x121, 0xF, 0xF, true)); }
__device__ __forceinline__ float dppz_ror2(float src) { return __builtin_bit_cast(float, __builtin_amdgcn_update_dpp(0, __builtin_bit_cast(int, src), 0x122, 0xF, 0xF, true)); }
struct EpiAct {
    static constexpr bool PERM = true, AFTER_DRAIN = false;
    bf16_t* ACT; const float* cw; float* HG; float* HU; PG8_LAS float* halo; RowScale rs;
    static constexpr int NF = 11008;
    __device__ __forceinline__ void operator()(const f32x4 (&acc)[2][2][4][2], const Unit& u, int wr, int wc, int fr, int fq) const {
        const int cc = wc * 32 + 8 * fq, col = u.pn * 128 + cc;
        f32x4 wq[2][3];
#pragma unroll
        for (int n = 0; n < 2; ++n) { wq[n][0] = *(const f32x4*)(cw + col + 4 * n); wq[n][1] = *(const f32x4*)(cw + NF + col + 4 * n); wq[n][2] = *(const f32x4*)(cw + 2 * NF + col + 4 * n); }
        if (rs.need(u.pm * BM)) rs.fill(u.pm * BM, (wr * 4 + wc) * 64 + fq * 16 + fr);
#pragma unroll
        for (int ai = 0; ai < 2; ++ai) if (fr >= 14) { PG8_LAS float* h = halo + ((2 * ai + wr) * 2 + (fr - 14)) * 128 + cc;
            *(PG8_LAS f32x4*)h = acc[ai][0][3][0]; *(PG8_LAS f32x4*)(h + 4) = acc[ai][0][3][1]; }
        asm volatile("s_waitcnt lgkmcnt(0)" ::: "memory"); __builtin_amdgcn_s_barrier(); asm volatile("" ::: "memory");
        const PG8_LAS float* rl = rs.rr + wr * 64 + fr;
        if (wr == 1 && fr >= 14) { const float r = rl[HALF + 48]; float* g = HG + ((size_t)u.pm * 4 + 2 + (fr - 14)) * NF + col; *(f32x4*)g = acc[1][0][3][0] * r; *(f32x4*)(g + 4) = acc[1][0][3][1] * r; }
        if (wr == 0 && fr < 2) { const float r = rl[0]; float* g = HG + ((size_t)u.pm * 4 + fr) * NF + col; *(f32x4*)g = acc[0][0][0][0] * r; *(f32x4*)(g + 4) = acc[0][0][0][1] * r;
            float* uu = HU + ((size_t)u.pm * 2 + fr) * NF + col; *(f32x4*)uu = acc[0][1][0][0] * r; *(f32x4*)(uu + 4) = acc[0][1][0][1] * r; }
        typedef unsigned u32x2 __attribute__((ext_vector_type(2)));
        const float m0 = fr == 0 ? 1.f : 0.f, m01 = fr < 2 ? 1.f : 0.f;
#pragma unroll
        for (int n = 0; n < 2; ++n) {
            const f32x4 w0 = wq[n][0], w1 = wq[n][1], w2 = wq[n][2]; const f32x4 w1m = w1 * m0, w0m = w0 * m01;
#pragma unroll
            for (int ai = 0; ai < 2; ++ai) {
                const int chunk = 2 * ai + wr;
                f32x4 gp;
                if (chunk > 0) { const PG8_LAS float* h = halo + ((chunk - 1) * 2) * 128 + cc + 4 * n;
                    const float s62 = rs.rr[(chunk - 1) * 64 + 62], s63 = rs.rr[(chunk - 1) * 64 + 63];
                    const f32x4 r62 = *(const PG8_LAS f32x4*)h * s62, r63 = *(const PG8_LAS f32x4*)(h + 128) * s63; gp = fr == 15 ? r63 : r62; }
                else { gp = (f32x4){0.f, 0.f, 0.f, 0.f}; }
#pragma unroll
                for (int m = 0; m < 4; ++m) {
                    float a[4]; const float rv = rl[ai * HALF + m * 16];
                    const f32x4 g = acc[ai][0][m][n] * rv; f32x4 y = w2 * g;
                    asm("s_nop 1\n\t"
                        "v_fmac_f32_dpp %0, %4, %12 row_shr:1 row_mask:0xf bank_mask:0xf\n\tv_fmac_f32_dpp %1, %5, %13 row_shr:1 row_mask:0xf bank_mask:0xf\n\t"
                        "v_fmac_f32_dpp %2, %6, %14 row_shr:1 row_mask:0xf bank_mask:0xf\n\tv_fmac_f32_dpp %3, %7, %15 row_shr:1 row_mask:0xf bank_mask:0xf\n\t"
                        "v_fmac_f32_dpp %0, %4, %16 row_shr:2 row_mask:0xf bank_mask:0xf\n\tv_fmac_f32_dpp %1, %5, %17 row_shr:2 row_mask:0xf bank_mask:0xf\n\t"
                        "v_fmac_f32_dpp %2, %6, %18 row_shr:2 row_mask:0xf bank_mask:0xf\n\tv_fmac_f32_dpp %3, %7, %19 row_shr:2 row_mask:0xf bank_mask:0xf\n\t"
                        "v_fmac_f32_dpp %0, %8, %20 row_ror:1 row_mask:0xf bank_mask:0xf\n\tv_fmac_f32_dpp %1, %9, %21 row_ror:1 row_mask:0xf bank_mask:0xf\n\t"
                        "v_fmac_f32_dpp %2, %10, %22 row_ror:1 row_mask:0xf bank_mask:0xf\n\tv_fmac_f32_dpp %3, %11, %23 row_ror:1 row_mask:0xf bank_mask:0xf\n\t"
                        "v_fmac_f32_dpp %0, %8, %24 row_ror:2 row_mask:0xf bank_mask:0xf\n\tv_fmac_f32_dpp %1, %9, %25 row_ror:2 row_mask:0xf bank_mask:0xf\n\t"
                        "v_fmac_f32_dpp %2, %10, %26 row_ror:2 row_mask:0xf bank_mask:0xf\n\tv_fmac_f32_dpp %3, %11, %27 row_ror:2 row_mask:0xf bank_mask:0xf"
                        : "+v"(y[0]), "+v"(y[1]), "+v"(y[2]), "+v"(y[3])
                        : "v"(g[0]), "v"(g[1]), "v"(g[2]), "v"(g[3]), "v"(gp[0]), "v"(gp[1]), "v"(gp[2]), "v"(gp[3]),
                          "v"(w1[0]), "v"(w1[1]), "v"(w1[2]), "v"(w1[3]), "v"(w0[0]), "v"(w0[1]), "v"(w0[2]), "v"(w0[3]),
                          "v"(w1m[0]), "v"(w1m[1]), "v"(w1m[2]), "v"(w1m[3]), "v"(w0m[0]), "v"(w0m[1]), "v"(w0m[2]), "v"(w0m[3]));
#pragma unroll
                    for (int e = 0; e < 4; ++e) a[e] = y[e] * __builtin_amdgcn_rcpf(1.0f + __expf(-y[e])) * (acc[ai][1][m][n][e] * rv);
                    gp = g;
                    u32x2 pk; pk.x = cvt_pk_bf16(a[0], a[1]); pk.y = cvt_pk_bf16(a[2], a[3]);
                    if (!(chunk == 0 && m == 0 && fr < 2)) *(u32x2*)(ACT + (size_t)(u.pm * BM + ai * HALF + wr * 64 + m * 16 + fr) * NF + col + 4 * n) = pk;
                }
            }
        }
    }
};
}
namespace fox {
typedef short bf16x8 __attribute__((ext_vector_type(8)));
typedef short s16x4 __attribute__((ext_vector_type(4)));
typedef float f32x16 __attribute__((ext_vector_type(16)));
typedef float f32x4 __attribute__((ext_vector_type(4)));
typedef unsigned u32x4 __attribute__((ext_vector_type(4)));
typedef unsigned short bf16;
constexpr int D = 128, SEQ = 8192, NHEAD = 16, OSTR = 4096;
constexpr float THR = 8.f;
constexpr float SCALE = 0.08838834764831845f;
constexpr int NW = 8, QBLK = 32, KVBLK = 64, QB = NW * QBLK;
constexpr int SHM_V = KVBLK * D * 2, SHM_K = KVBLK * D * 2;
constexpr int LDS_ATT = 2 * SHM_V + 2 * SHM_K + NW * 64 * 4;
constexpr int LDS_T = 69632;
constexpr int LDS_TOTAL = LDS_T + SEQ * 4;

#define KSWZ(row, colB) ((row) * 256 + ((colB) ^ (((row) & 7) << 4)))
#define SBAR() __builtin_amdgcn_sched_barrier(0)
__device__ __forceinline__ int v_st(int k, int c) { const int kk = (k & ~0xC) | ((k & 4) << 1) | ((k & 8) >> 1); return ((kk >> 3) * 4 + (c >> 5)) * 512 + ((kk & 7) * 32 + (c & 31)) * 2; }
__device__ __forceinline__ int v_rd_base(int lane) { return ((lane & 3) << 3) | (((lane >> 2) & 3) << 6) | (((lane >> 4) & 1) << 5) | (((lane >> 5) & 1) << 8); }
constexpr int v_rd_off(int d0, int ks, int half) { return d0 * 512 + ks * 4096 + half * 2048; }
__device__ __forceinline__ int crow(int r, int hi) { return (r & 3) + 8 * (r >> 2) + 4 * hi; }
typedef float cvtpk_f2 __attribute__((ext_vector_type(2))); typedef __bf16 cvtpk_b2 __attribute__((ext_vector_type(2)));
__device__ __forceinline__ unsigned cvtpk(float lo, float hi) { const cvtpk_f2 v = {lo, hi}; return __builtin_bit_cast(unsigned, __builtin_convertvector(v, cvtpk_b2)); }
__device__ __forceinline__ bf16x8 load8(const bf16* p) { return *reinterpret_cast<const bf16x8*>(p); }
__device__ __forceinline__ void mask_tile(f32x16& p0, f32x16& p1, int dq, unsigned W) {
    const float NEG = -__builtin_inff();
#pragma unroll
    for (int r = 0; r < 16; ++r) {
        const int c = (r & 3) + 8 * (r >> 2);
        if ((unsigned)(dq - c) >= W) p0[r] = NEG;
        if ((unsigned)(dq - c - 32) >= W) p1[r] = NEG;
    }
}
__device__ __forceinline__ void partialSM(f32x16& p0, f32x16& p1, float& m_reg, float& mn, float& alpha) {
    float pmax = p0[0]; for (int r = 1; r < 16; ++r) pmax = fmaxf(pmax, p0[r]); for (int r = 0; r < 16; ++r) pmax = fmaxf(pmax, p1[r]);
    { auto rr = __builtin_amdgcn_permlane32_swap(__float_as_uint(pmax), __float_as_uint(pmax), false, false);
      pmax = fmaxf(__uint_as_float(rr[0]), __uint_as_float(rr[1])); }
    constexpr float C2 = 1.4426950408889634f * SCALE;
    if (__builtin_expect(__all((pmax - m_reg) * SCALE <= THR), 1)) { mn = m_reg; alpha = 1.f; }
    else { mn = fmaxf(m_reg, pmax); alpha = __builtin_amdgcn_exp2f((m_reg - mn) * C2); m_reg = mn; }
    const float mnL = -mn * C2;
    for (int r = 0; r < 16; ++r) p0[r] = fmaf(p0[r], C2, mnL); for (int r = 0; r < 16; ++r) p1[r] = fmaf(p1[r], C2, mnL);
    for (int r = 0; r < 16; ++r) p0[r] = __builtin_amdgcn_exp2f(p0[r]);
}
__device__ __forceinline__ void finishSM(f32x16& p0, f32x16& p1, float alpha, float& l_reg, bf16x8& pa0, bf16x8& pa1, bf16x8& pa2, bf16x8& pa3) {
    for (int r = 0; r < 16; ++r) p1[r] = __builtin_amdgcn_exp2f(p1[r]);
    float ps = 0; for (int r = 0; r < 16; ++r) ps += p0[r]; for (int r = 0; r < 16; ++r) ps += p1[r];
    { auto rr = __builtin_amdgcn_permlane32_swap(__float_as_uint(ps), __float_as_uint(ps), false, false);
      ps = __uint_as_float(rr[0]) + __uint_as_float(rr[1]); }
    l_reg = l_reg * alpha + ps;
#define PK4(P, B_, OUT) do { unsigned a0 = cvtpk(P[B_+0], P[B_+1]), a1 = cvtpk(P[B_+2], P[B_+3]);                          \
        unsigned b0 = cvtpk(P[B_+4], P[B_+5]), b1 = cvtpk(P[B_+6], P[B_+7]);                                             \
        auto r0 = __builtin_amdgcn_permlane32_swap(a0, b0, false, false); auto r1 = __builtin_amdgcn_permlane32_swap(a1, b1, false, false); \
        u32x4 w = {r0[0], r1[0], r0[1], r1[1]}; OUT = *reinterpret_cast<bf16x8*>(&w); } while (0)
    PK4(p0, 0, pa0); PK4(p0, 8, pa1); PK4(p1, 0, pa2); PK4(p1, 8, pa3);
#undef PK4
}
template <int KB>
__device__ __forceinline__ void qkt(f32x16& p0, f32x16& p1, const char* K_lds, int r32, int hi, const bf16x8* qr, const float* tb) {
    { const f32x4 a0 = *(const f32x4*)(tb), a1 = *(const f32x4*)(tb + 8), a2 = *(const f32x4*)(tb + 16), a3 = *(const f32x4*)(tb + 24);
      const f32x4 b0 = *(const f32x4*)(tb + 32), b1 = *(const f32x4*)(tb + 40), b2 = *(const f32x4*)(tb + 48), b3 = *(const f32x4*)(tb + 56);
      p0 = (f32x16){a0[0], a0[1], a0[2], a0[3], a1[0], a1[1], a1[2], a1[3], a2[0], a2[1], a2[2], a2[3], a3[0], a3[1], a3[2], a3[3]};
      p1 = (f32x16){b0[0], b0[1], b0[2], b0[3], b1[0], b1[1], b1[2], b1[3], b2[0], b2[1], b2[2], b2[3], b3[0], b3[1], b3[2], b3[3]}; }
    const char* kb[4];
#pragma unroll
    for (int dd = 0; dd < 4; ++dd) kb[dd] = K_lds + KB * SHM_K + KSWZ(r32, (dd * 16 + hi * 8) * 2);
#pragma unroll
    for (int d0 = 0; d0 < 8; ++d0) { const char* a = kb[d0 & 3] + (d0 >> 2) * 128;
        bf16x8 b0 = *reinterpret_cast<const bf16x8*>(a);
        bf16x8 b1 = *reinterpret_cast<const bf16x8*>(a + 32 * 256);
        p0 = __builtin_amdgcn_mfma_f32_32x32x16_bf16(b0, qr[d0], p0, 0, 0, 0);
        p1 = __builtin_amdgcn_mfma_f32_32x32x16_bf16(b1, qr[d0], p1, 0, 0, 0); }
}
template <int VB>
__device__ __forceinline__ void pv_tile(f32x16* o, int vb0, bf16x8 pa0, bf16x8 pa1, bf16x8 pa2, bf16x8 pa3) {
#define TRRD(dst, off) asm volatile("ds_read_b64_tr_b16 %0, %1 offset:%2" : "=&v"(dst) : "v"(vb0), "i"(off) : "memory")
#define PV_D0(d0) do { s16x4 l0, l1, l2, l3, h0, h1, h2, h3; constexpr int b_ = VB * SHM_V + v_rd_off(d0, 0, 0); \
        TRRD(l0, b_); TRRD(h0, b_ + 2048); TRRD(l1, b_ + 4096); TRRD(h1, b_ + 6144); TRRD(l2, b_ + 8192); TRRD(h2, b_ + 10240); TRRD(l3, b_ + 12288); TRRD(h3, b_ + 14336); \
        asm volatile("s_waitcnt lgkmcnt(0)" ::: "memory"); SBAR();   \
        o[d0] = __builtin_amdgcn_mfma_f32_32x32x16_bf16(pa0, (bf16x8){l0[0], l0[1], l0[2], l0[3], h0[0], h0[1], h0[2], h0[3]}, o[d0], 0, 0, 0);   \
        o[d0] = __builtin_amdgcn_mfma_f32_32x32x16_bf16(pa1, (bf16x8){l1[0], l1[1], l1[2], l1[3], h1[0], h1[1], h1[2], h1[3]}, o[d0], 0, 0, 0);   \
        o[d0] = __builtin_amdgcn_mfma_f32_32x32x16_bf16(pa2, (bf16x8){l2[0], l2[1], l2[2], l2[3], h2[0], h2[1], h2[2], h2[3]}, o[d0], 0, 0, 0);   \
        o[d0] = __builtin_amdgcn_mfma_f32_32x32x16_bf16(pa3, (bf16x8){l3[0], l3[1], l3[2], l3[3], h3[0], h3[1], h3[2], h3[3]}, o[d0], 0, 0, 0); } while (0)
    PV_D0(0); PV_D0(1); PV_D0(2); PV_D0(3);
#undef PV_D0
#undef TRRD
}
struct BlockRef { const bf16* Q; const bf16* K; const bf16* V; bf16* O; int P0; int jlo; };
struct Seam { bf16x8 qr[8]; bf16x8 st_v0, st_v1, st_k0, st_k1; };
#define ROWU(p, k0, rr) ((const char*)(p) + (size_t)((k0) + (rr)) * (D * 2))
#define LD8U(pu) (*(const bf16x8*)((pu) + lofs))
#define VMW() asm volatile("s_waitcnt vmcnt(0)" ::: "memory")
#define VMWN(n) asm volatile("s_waitcnt vmcnt(%0)" :: "i"(n) : "memory")
#define SLOAD_H(Kp, Vp, k0) do { S.st_v0 = LD8U(ROWU(Vp, k0, 0)); S.st_v1 = LD8U(ROWU(Vp, k0, 32));              \
                         S.st_k0 = LD8U(ROWU(Kp, k0, 0)); S.st_k1 = LD8U(ROWU(Kp, k0, 32)); } while (0)
#define SWRITE_HK(bf) do { *(bf16x8*)(K_lds + (bf) * SHM_K + kws) = S.st_k0; *(bf16x8*)(K_lds + (bf) * SHM_K + kws + 32 * 256) = S.st_k1; } while (0)
#define SWRITE_HV(bf) do { *(bf16x8*)(V_lds + (bf) * SHM_V + vst0) = S.st_v0; *(bf16x8*)(V_lds + (bf) * SHM_V + vst1) = S.st_v1; } while (0)
#define SWRITE_H(bf) do { SWRITE_HV(bf); SWRITE_HK(bf); } while (0)
__device__ __forceinline__ void fox_prime(const BlockRef& cur, char* lds, Seam& S, const int tid) {
    const int wid = __builtin_amdgcn_readfirstlane(tid >> 6), lane = tid & 63, r32 = lane & 31, hi = lane >> 5;
    const int sr = tid >> 4, sc = (tid & 15) * 8, kws = KSWZ(sr, sc * 2); char* K_lds = lds + 2 * SHM_V; const unsigned lofs = (unsigned)(sr * D + sc) * 2u;
    { const unsigned qofs = (unsigned)(r32 * D + hi * 8) * 2u; const char* qb_ = (const char*)cur.Q + (size_t)(wid * QBLK) * (D * 2);
      for (int d0 = 0; d0 < 8; ++d0) S.qr[d0] = *(const bf16x8*)(qb_ + qofs + d0 * 32); }
    SLOAD_H(cur.K, cur.V, cur.jlo * KVBLK); VMW(); SWRITE_HK(0);
    __syncthreads();
}
__device__ __forceinline__ void fox_block(const BlockRef& cur, const BlockRef& nxt, char* lds, Seam& S, const int tid) {
    const int wid = __builtin_amdgcn_readfirstlane(tid >> 6), lane = tid & 63, r32 = lane & 31, hi = lane >> 5;
    const int j_lo = cur.jlo; const int NT = (cur.P0 + QB) / KVBLK - j_lo;
    const int qlo = cur.P0 + wid * QBLK, qm = qlo + r32 - 4 * hi;
    char* V_lds = lds; char* K_lds = lds + 2 * SHM_V;
    float* ws = (float*)(lds + 2 * SHM_V + 2 * SHM_K) + wid * 64; float* li_l = ws, * al_l = ws + 32;
    const float* tbl = (const float*)(lds + LDS_T) + 4 * hi;
    float m_reg = -1e30f, l_reg = 0; f32x16 o[4] = {};
    const int sr = tid >> 4, sc = (tid & 15) * 8, vst0 = v_st(sr, sc), vst1 = v_st(32 + sr, sc), kws = KSWZ(sr, sc * 2); const unsigned lofs = (unsigned)(sr * D + sc) * 2u;
    const int vb0 = (int)(uintptr_t)V_lds + v_rd_base(lane);
    const bf16* Kh = cur.K; const bf16* Vh = cur.V;
    constexpr int W = 1 << 30;
#define RESC(a) do { if (__any((a) < 1.f)) { if (hi == 0) al_l[r32] = (a); asm volatile("s_waitcnt lgkmcnt(0)" ::: "memory");              \
                     for (int d_ = 0; d_ < 4; ++d_) for (int r = 0; r < 16; ++r) o[d_][r] *= al_l[crow(r, hi)]; } } while (0)
#define KBASE(t) ((j_lo + (t)) * KVBLK)
#define MASKT(P0_, P1_, t) do { const int kb_ = KBASE(t); if (kb_ + KVBLK - 1 > qlo) mask_tile(P0_, P1_, qm - kb_, (unsigned)W); } while (0)
    constexpr int NQL = 8;
#define SEAM_K0() do { VMWN(NQL); SWRITE_HK(0); SBAR(); } while (0)
    f32x16 pA0, pA1, pB0, pB1; float mnA, mnB, alA, alB; bf16x8 pa0, pa1, pa2, pa3;
    SWRITE_HV(0); SBAR();
    if (NT > 1) { SLOAD_H(Kh, Vh, KBASE(1)); }
    SBAR(); qkt<0>(pA0, pA1, K_lds, r32, hi, S.qr, tbl + KBASE(0));
    MASKT(pA0, pA1, 0); partialSM(pA0, pA1, m_reg, mnA, alA);
    if (NT > 1) { VMW(); SWRITE_H(1); }
    __syncthreads();
#define HALF_STEP(PX0, PX1, mnX, alX, PY0, PY1, alY, t, KB, VB, SB) do {                                                      \
        SBAR(); qkt<KB>(PX0, PX1, K_lds, r32, hi, S.qr, tbl + KBASE(t));                                                      \
        finishSM(PY0, PY1, alY, l_reg, pa0, pa1, pa2, pa3); SBAR();                                                           \
        if ((t) + 1 < NT) { SLOAD_H(Kh, Vh, KBASE((t) + 1)); SBAR(); }                                                        \
        pv_tile<VB>(o, vb0, pa0, pa1, pa2, pa3); MASKT(PX0, PX1, (t)); partialSM(PX0, PX1, m_reg, mnX, alX);                  \
        __syncthreads();                                                                                                      \
        if ((t) + 1 < NT) { VMW(); SWRITE_H(SB); }                                                                            \
        RESC(alX); __syncthreads(); } while (0)
    for (int t = 1; t + 1 < NT; t += 2) {
        HALF_STEP(pB0, pB1, mnB, alB, pA0, pA1, alA, t, 1, 0, 0);
        HALF_STEP(pA0, pA1, mnA, alA, pB0, pB1, alB, t + 1, 0, 1, 1);
    }
    const bool even = (NT & 1) == 0;
    if (even) { SBAR(); qkt<1>(pB0, pB1, K_lds, r32, hi, S.qr, tbl + KBASE(NT - 1)); SBAR(); }
    SLOAD_H(nxt.K, nxt.V, nxt.jlo * KVBLK); SBAR();
    { const unsigned qofs = (unsigned)(r32 * D + hi * 8) * 2u; const char* qb_ = (const char*)nxt.Q + (size_t)(wid * QBLK) * (D * 2);
#pragma unroll
      for (int d0 = 0; d0 < 8; ++d0) S.qr[d0] = *(const bf16x8*)(qb_ + qofs + d0 * 32); }
    SBAR();
    finishSM(pA0, pA1, alA, l_reg, pa0, pa1, pa2, pa3); SBAR();
    pv_tile<0>(o, vb0, pa0, pa1, pa2, pa3);
    if (even) { MASKT(pB0, pB1, NT - 1); partialSM(pB0, pB1, m_reg, mnB, alB); __syncthreads(); RESC(alB);
        finishSM(pB0, pB1, alB, l_reg, pa0, pa1, pa2, pa3); SBAR(); pv_tile<1>(o, vb0, pa0, pa1, pa2, pa3); }
    SBAR(); SEAM_K0();
    if (hi == 0) li_l[r32] = l_reg; asm volatile("s_waitcnt lgkmcnt(0)" ::: "memory");
    float rli[16];
#pragma unroll
    for (int r = 0; r < 16; ++r) rli[r] = __builtin_amdgcn_rcpf(li_l[crow(r, hi)]);
    bf16* Ow = cur.O + (size_t)(wid * QBLK) * OSTR;
#pragma unroll
    for (int r = 0; r < 16; ++r) { const int orow = crow(r, hi);
#pragma unroll
        for (int d0 = 0; d0 < 4; ++d0) { const float v = o[d0][r] * rli[r];
            const float vn = __shfl_xor(v, 1);
            if ((r32 & 1) == 0) *(unsigned*)(Ow + (size_t)orow * OSTR + d0 * 32 + r32) = cvtpk(v, vn); } }
    __syncthreads();
#undef RESC
#undef KBASE
#undef MASKT
#undef SEAM_K0
#undef HALF_STEP
}
#undef ROWU
#undef LD8U
#undef VMW
#undef VMWN
#undef SLOAD_H
#undef SWRITE_HK
#undef SWRITE_HV
#undef SWRITE_H
#undef KSWZ
#undef SBAR
}
#define GAS __attribute__((address_space(1)))
#define LAS __attribute__((address_space(3)))
typedef unsigned short bf16;
typedef unsigned v4u __attribute__((ext_vector_type(4)));
typedef float f32x4 __attribute__((ext_vector_type(4)));
typedef short bf16x8 __attribute__((ext_vector_type(8)));
typedef GAS unsigned gu32;
typedef GAS unsigned long long gu64;
#define RLX_AGENT __ATOMIC_RELAXED, __HIP_MEMORY_SCOPE_AGENT
#define LDS_WAIT() asm volatile("s_waitcnt lgkmcnt(0)" ::: "memory")
#define VM_WAIT() asm volatile("s_waitcnt vmcnt(0)" ::: "memory")
__device__ __forceinline__ unsigned long long rt() { return __builtin_amdgcn_s_memrealtime(); }
__device__ __forceinline__ unsigned f2bf(float f) { unsigned u = __builtin_bit_cast(unsigned, f); return (u + 0x7fffu + ((u >> 16) & 1u)) >> 16; }
typedef float pk2_f32x2 __attribute__((ext_vector_type(2))); typedef __bf16 pk2_bf16x2 __attribute__((ext_vector_type(2)));
__device__ __forceinline__ unsigned pk2(float lo, float hi) { const pk2_f32x2 v = {lo, hi}; return __builtin_bit_cast(unsigned, __builtin_convertvector(v, pk2_bf16x2)); }

#define XB_TMO      128
#define XB_XCNT(j)  (256  + 64 * (j))
#define XB_XSUB(j)  (1280 + 64 * (j))
#define XB_XGEN(j)  (2304 + 64 * (j))
#define XB_TOP      3328
#define XB_TOPGEN   3392
#define XCD_BAR_WORDS 3456
#define XB_TOP2(p)    (3456 + 32 * (p))
#define XB_TOPGEN2(p) (3712 + 32 * (p))
#define XB_SPIN_CAP (1u << 18)

__device__ __forceinline__ unsigned xb_ld(unsigned* p)              { return __hip_atomic_load(p, __ATOMIC_RELAXED, __HIP_MEMORY_SCOPE_AGENT); }
__device__ __forceinline__ unsigned xb_add(unsigned* p, unsigned v) { return __hip_atomic_fetch_add(p, v, __ATOMIC_RELAXED, __HIP_MEMORY_SCOPE_AGENT); }
__device__ __forceinline__ unsigned xb_xcc_id() { return (unsigned)__builtin_amdgcn_s_getreg((3 << 11) | 20) & 0xFu; }
#define XB_SPIN(cond, bar) do { unsigned _sp = 0; while (cond) { __builtin_amdgcn_s_sleep(1); \
    if ((++_sp & 255u) == 0u) { if (xb_ld(&(bar)[XB_TMO])) break; if (_sp > XB_SPIN_CAP) { atomicAdd(&(bar)[XB_TMO], 1u); break; } } } } while (0)

struct XcdBarrier {
    unsigned* bar; unsigned x;
    volatile LAS unsigned* st;
};

__device__ __forceinline__ XcdBarrier xcd_barrier_post(unsigned* bar, volatile LAS unsigned* st) {
    XcdBarrier b; b.bar = bar; b.x = xb_xcc_id(); b.st = st;
    if (threadIdx.x == 0) (void)xb_add(&bar[XB_XCNT(b.x)], 1u + (((unsigned)blockIdx.x & 7u) != b.x ? 0x10000u : 0u));
    return b;
}
__device__ __forceinline__ void xcd_barrier_complete(unsigned* bar, unsigned x, unsigned& nloc, unsigned& nx, unsigned& pairok) {
    const unsigned G = gridDim.x * gridDim.y * gridDim.z;
    unsigned sum, cnt, mine, mis, sp = 0u;
    for (;;) {
        sum = 0u; cnt = 0u; mine = 0u; mis = 0u;
#pragma unroll
        for (unsigned j = 0; j < 16; ++j) { const unsigned w = xb_ld(&bar[XB_XCNT(j)]), c = w & 0xffffu; mis += w >> 16; sum += c; cnt += (c > 0u) ? 1u : 0u; mine = (j == x) ? c : mine; }
        if (sum == G) break;
        __builtin_amdgcn_s_sleep(1);
        if ((++sp & 255u) == 0u) { if (xb_ld(&bar[XB_TMO])) break; if (sp > XB_SPIN_CAP) { atomicAdd(&bar[XB_TMO], 1u); break; } }
    }
    nloc = mine > 0u ? mine : 1u; nx = cnt > 0u ? cnt : 1u;
    pairok = (sum == G && G == 256u && mis == 0u && cnt == 8u) ? 1u : 0u;
}

__device__ __forceinline__ void xcd_barrier(const XcdBarrier& b) {
    asm volatile("s_waitcnt vmcnt(0)" ::: "memory");
    __syncthreads();
    if (threadIdx.x == 0) {
        unsigned* bar = b.bar;
        __builtin_amdgcn_s_waitcnt(0);
        unsigned nloc = b.st[0], nx = b.st[1];
        if (nloc == 0u) { unsigned pk = 0u; xcd_barrier_complete(bar, b.x, nloc, nx, pk); b.st[0] = nloc; b.st[1] = nx; b.st[2] = pk; }
        const unsigned old = xb_add(&bar[XB_XSUB(b.x)], 1u);
        const unsigned gen = old / nloc;
        if (old + 1u == (gen + 1u) * nloc) {
            __builtin_amdgcn_fence(__ATOMIC_RELEASE, "agent");
            asm volatile("s_waitcnt vmcnt(0)" ::: "memory");
            const unsigned og = xb_add(&bar[XB_TOP], 1u);
            const unsigned tg = og / nx;
            if (og + 1u == (tg + 1u) * nx) xb_add(&bar[XB_TOPGEN], 1u);
            else XB_SPIN(xb_ld(&bar[XB_TOPGEN]) == tg, bar);
            __builtin_amdgcn_fence(__ATOMIC_ACQUIRE, "agent");
            xb_add(&bar[XB_XGEN(b.x)], 1u);
            asm volatile("s_waitcnt vmcnt(0)" ::: "memory");
        } else {
            XB_SPIN(xb_ld(&bar[XB_XGEN(b.x)]) == gen, bar);
            __builtin_amdgcn_fence(__ATOMIC_ACQUIRE, "agent");
            asm volatile("s_waitcnt vmcnt(0)" ::: "memory");
        }
    }
    __syncthreads();
}

__device__ __forceinline__ void xcd_barrier_pair(const XcdBarrier& b) {
    asm volatile("s_waitcnt vmcnt(0)" ::: "memory");
    __syncthreads();
    if (threadIdx.x == 0) {
        unsigned* bar = b.bar;
        __builtin_amdgcn_s_waitcnt(0);
        const unsigned nloc = b.st[0], p = b.x >> 1;
        const unsigned old = xb_add(&bar[XB_XSUB(b.x)], 1u);
        const unsigned gen = old / nloc;
        if (old + 1u == (gen + 1u) * nloc) {
            __builtin_amdgcn_fence(__ATOMIC_RELEASE, "agent");
            asm volatile("s_waitcnt vmcnt(0)" ::: "memory");
            const unsigned og = xb_add(&bar[XB_TOP2(p)], 1u);
            const unsigned tg = og >> 1;
            if (og + 1u == (tg + 1u) * 2u) xb_add(&bar[XB_TOPGEN2(p)], 1u);
            else XB_SPIN(xb_ld(&bar[XB_TOPGEN2(p)]) == tg, bar);
            __builtin_amdgcn_fence(__ATOMIC_ACQUIRE, "agent");
            xb_add(&bar[XB_XGEN(b.x)], 1u);
            asm volatile("s_waitcnt vmcnt(0)" ::: "memory");
        } else {
            XB_SPIN(xb_ld(&bar[XB_XGEN(b.x)]) == gen, bar);
            __builtin_amdgcn_fence(__ATOMIC_ACQUIRE, "agent");
            asm volatile("s_waitcnt vmcnt(0)" ::: "memory");
        }
    }
    __syncthreads();
}
__device__ __forceinline__ void xcd_pair_wait(const XcdBarrier& b, unsigned p0, unsigned p1, unsigned k) {
    if (threadIdx.x == 0) {
        for (unsigned p = p0; p <= p1; ++p) XB_SPIN(xb_ld(&b.bar[XB_TOPGEN2(p)]) < k, b.bar);
        __builtin_amdgcn_fence(__ATOMIC_ACQUIRE, "agent");
        asm volatile("s_waitcnt vmcnt(0)" ::: "memory");
    }
    __syncthreads();
}
constexpr int NWAVES = 8;
constexpr int SEQ = 8192, DM = 4096, HW = 2048, DFF = 11008, NH = 16;
constexpr float EPS = 1e-6f;
constexpr float ATT_SCALE = 0.08838834764831845f;
constexpr size_t MiB = 1u << 20;
constexpr size_t WS_CTL = 0, CTL_ZERO_BYTES = 64 * 1024;
constexpr size_t WS_WF = 1 * MiB;
constexpr size_t WS_WSGU = 2 * MiB;
constexpr size_t WS_LF = 3 * MiB;
constexpr size_t WS_T = 4 * MiB;
constexpr size_t WS_SSP = 5 * MiB;
constexpr size_t WS_WPOOL = 6 * MiB;
constexpr size_t WS_W0IN = 8 * MiB;
constexpr size_t WS_W0OUT = 72 * MiB;
constexpr size_t WS_W0UP = 104 * MiB;
constexpr size_t WS_W0DN = 276 * MiB;
constexpr size_t WS_W1IN = 362 * MiB;
constexpr size_t WS_W1OUT = 442 * MiB;
constexpr size_t WS_W1UP = 474 * MiB;
constexpr size_t WS_W1DN = 646 * MiB;
constexpr size_t WS_XN = 732 * MiB;
constexpr size_t WS_ACT = 796 * MiB;
constexpr size_t WS_R = 968 * MiB;
constexpr size_t WS_QKV = WS_R;
constexpr size_t WS_ZP = WS_R + 96 * MiB;
constexpr size_t WS_PL = WS_R + 128 * MiB;
constexpr size_t WS_P1 = WS_R;
constexpr size_t WS_VST = WS_R + 128 * MiB;
constexpr size_t WS_CC = WS_R + 160 * MiB;
constexpr size_t WS_GU = WS_R;
constexpr size_t WS_HG = WS_R + 256 * MiB;
constexpr size_t WS_HU = WS_R + 264 * MiB;
constexpr size_t WS_END = WS_R + 344 * MiB;
constexpr int CW_BAR = 4096;
constexpr int RING_BYTES = 131072, LDSCTL_OFF = RING_BYTES, MISC_OFF = LDSCTL_OFF + 320, HALO_OFF = RING_BYTES + 1024, RR_OFF = HALO_OFF + 4096, RED_OFF = RR_OFF + 1024, LDS_BYTES = 147456;

struct Frame {
    LAS unsigned char* lds; volatile LAS unsigned* MISC; int wave, vcu, G;
};
__device__ __forceinline__ float wave_sum(float v) {
#pragma unroll
    for (int o = 1; o < 64; o <<= 1) v += __shfl_xor(v, o);
    return v;
}
__device__ __forceinline__ float bf2f(unsigned short b) { return __builtin_bit_cast(float, (unsigned)b << 16); }
__device__ __forceinline__ float bflo(unsigned w) { return __builtin_bit_cast(float, w << 16); }
__device__ __forceinline__ float bfhi(unsigned w) { return __builtin_bit_cast(float, w & 0xffff0000u); }
struct TrJob { const float* src; const float* gk; bf16* dst; int ld, K, k0; };
__device__ __forceinline__ void tr_load(float (&t)[32], const TrJob& j, int lane) {
    const float* sp = j.src + (size_t)(j.k0 + 32 * (lane >> 5)) * j.ld + (lane & 31);
#pragma unroll
    for (int i = 0; i < 32; ++i) t[i] = __builtin_nontemporal_load(sp + (size_t)i * j.ld);
}
__device__ __forceinline__ void tr_store(const float (&t)[32], const TrJob& j, LAS float* scr, int lane) {
    LAS unsigned char* sb = (LAS unsigned char*)scr;
    v4u w[4];
    if (j.gk) { const GAS f32x4* gp = (const GAS f32x4*)(j.gk + j.k0 + 32 * (lane >> 5));
#pragma unroll
        for (int q = 0; q < 4; ++q) { const f32x4 ga = gp[2 * q], gb = gp[2 * q + 1];
            w[q].x = pk2(t[8 * q] * ga.x, t[8 * q + 1] * ga.y); w[q].y = pk2(t[8 * q + 2] * ga.z, t[8 * q + 3] * ga.w); w[q].z = pk2(t[8 * q + 4] * gb.x, t[8 * q + 5] * gb.y); w[q].w = pk2(t[8 * q + 6] * gb.z, t[8 * q + 7] * gb.w); }
    } else {
#pragma unroll
        for (int q = 0; q < 4; ++q) { w[q].x = pk2(t[8 * q], t[8 * q + 1]); w[q].y = pk2(t[8 * q + 2], t[8 * q + 3]); w[q].z = pk2(t[8 * q + 4], t[8 * q + 5]); w[q].w = pk2(t[8 * q + 6], t[8 * q + 7]); }
    }
    { LAS v4u* wp = (LAS v4u*)(sb + (lane & 31) * 144 + (lane >> 5) * 64);
#pragma unroll
      for (int q = 0; q < 4; ++q) wp[q] = w[q]; }
    LDS_WAIT(); asm volatile("" ::: "memory");
    const int c = lane & 7;
#pragma unroll
    for (int jj = 0; jj < 4; ++jj) { const int n = (lane >> 3) + 8 * jj;
        *(GAS v4u*)(j.dst + (size_t)n * j.K + j.k0 + 8 * c) = *(const LAS v4u*)(sb + n * 144 + 16 * c); }
    LDS_WAIT(); asm volatile("" ::: "memory");
}
__device__ __forceinline__ int map_ident(int n) { return n; }
__device__ __forceinline__ int map_w0in(int n) { return n < 6144 ? n : n + 16; }
__device__ __forceinline__ int map_up(int n) { const int j = n >> 8, i = n & 255; return i < 128 ? 128 * j + i : DFF + 128 * j + (i - 128); }
__device__ __forceinline__ void xb_rows(const float* X, bf16* XB, float* ss, int m0, int mstep, int lane) {
    if (m0 >= SEQ) return;
    f32x4 v[16], vn[16];
    { const GAS f32x4* xr = (const GAS f32x4*)(X + (size_t)m0 * DM) + lane;
#pragma unroll
      for (int j = 0; j < 16; ++j) v[j] = __builtin_nontemporal_load(xr + 64 * j); }
    for (int m = m0; m < SEQ; m += mstep) {
        const bool more = m + mstep < SEQ;
        if (more) { const GAS f32x4* xr = (const GAS f32x4*)(X + (size_t)(m + mstep) * DM) + lane;
#pragma unroll
            for (int j = 0; j < 16; ++j) vn[j] = __builtin_nontemporal_load(xr + 64 * j); }
        float s = 0.f;
#pragma unroll
        for (int j = 0; j < 16; ++j) s += (v[j].x * v[j].x + v[j].y * v[j].y) + (v[j].z * v[j].z + v[j].w * v[j].w);
        s = wave_sum(s); if (lane == 0) ss[m] = s;
        GAS unsigned long long* o8 = (GAS unsigned long long*)(XB + (size_t)m * DM) + lane;
#pragma unroll
        for (int j = 0; j < 16; ++j) o8[64 * j] = (unsigned long long)pk2(v[j].x, v[j].y) | ((unsigned long long)pk2(v[j].z, v[j].w) << 32);
        if (more) {
#pragma unroll
            for (int j = 0; j < 16; ++j) v[j] = vn[j]; }
    }
}

struct Args { const float* in[24]; float* out; unsigned char* ws; int ph_lo, ph_hi; };
enum { I_X = 0, I_L0_MIXN, I_L0_WIN, I_L0_BF, I_L0_QG, I_L0_KG, I_L0_POOLW, I_L0_POOLS, I_L0_WOUT, I_L0_FFNN, I_L0_WUP, I_L0_FCONV, I_L0_WDN,
       I_L1_MIXN, I_L1_WIN, I_L1_CONVW, I_L1_SGUN, I_L1_SGUW, I_L1_SGUB, I_L1_WOUT, I_L1_FFNN, I_L1_WUP, I_L1_FCONV, I_L1_WDN };

constexpr int IT_W0IN = (4096 / 64) * (8192 / 32), IT_WOUT = (4096 / 64) * (4096 / 32), IT_UP = (4096 / 64) * (22016 / 32), IT_DN = (11008 / 64) * (4096 / 32),
              IT_W1IN = (4096 / 64) * (10240 / 32), IT_POOL = (512 / 64) * (512 / 32);
constexpr int P0_NITEMS = IT_W0IN;
constexpr int CV_TAIL = IT_UP / 2;
constexpr int CV_NITEMS = IT_W1IN + 2 * (IT_WOUT + IT_UP) + IT_DN + 4 * IT_POOL - CV_TAIL;
template <bool FIRST> __device__ __forceinline__ TrJob tr_job(const Args& a, int r) {
    unsigned char* ws = a.ws; TrJob j;
#define TRJOB(NIT, SRCI, LD, KD, ND, DSTOFF, MAP, GAIN) if (r < (NIT)) { constexpr int nb_ = (ND) / 32; const int kb_ = r / nb_, n0_ = 32 * (r % nb_); \
        j.src = a.in[SRCI] + MAP(n0_); j.gk = GAIN; j.dst = (bf16*)(ws + (DSTOFF)) + (size_t)n0_ * (KD); j.ld = LD; j.K = KD; j.k0 = 64 * kb_; return j; } r -= (NIT);
    if (FIRST) { TRJOB(IT_W0IN, I_L0_WIN, 8208, 4096, 8192, WS_W0IN, map_w0in, a.in[I_L0_MIXN]) }
    TRJOB(IT_WOUT, I_L0_WOUT, 4096, 4096, 4096, WS_W0OUT, map_ident, nullptr)
    TRJOB(IT_UP, I_L0_WUP, 22016, 4096, 22016, WS_W0UP, map_up, a.in[I_L0_FFNN])
    TRJOB(IT_DN, I_L0_WDN, 4096, 11008, 4096, WS_W0DN, map_ident, nullptr)
    TRJOB(IT_W1IN, I_L1_WIN, 10240, 4096, 10240, WS_W1IN, map_ident, a.in[I_L1_MIXN])
    TRJOB(IT_WOUT, I_L1_WOUT, 4096, 4096, 4096, WS_W1OUT, map_ident, nullptr)
    if (r < 4 * IT_POOL) { const int g_ = r / IT_POOL; r -= g_ * IT_POOL; constexpr int nb_ = 512 / 32; const int kb_ = r / nb_, n0_ = 32 * (r % nb_);
      j.src = a.in[I_L0_POOLW] + (size_t)g_ * 512 * 512 + n0_; j.gk = nullptr; j.dst = (bf16*)(ws + WS_WPOOL) + (size_t)g_ * 512 * 512 + (size_t)n0_ * 512; j.ld = 512; j.K = 512; j.k0 = 64 * kb_; return j; }
    r -= 4 * IT_POOL;
    TRJOB(IT_UP, I_L1_WUP, 22016, 4096, 22016, WS_W1UP, map_up, a.in[I_L1_FFNN])
#undef TRJOB
    return j;
}
__device__ __forceinline__ void p0_prologue(Frame& F, const Args& a) {
    unsigned char* ws = a.ws;
    LAS float* scr = (LAS float*)(F.lds + F.wave * 16384);
    const int gw = F.vcu * NWAVES + F.wave, NGW = F.G * NWAVES;
    constexpr int NITEMS = P0_NITEMS;
    if (gw < NITEMS) {
        float t[32], t2[32]; TrJob j0 = tr_job<true>(a, gw), j1 = j0; const int lane = (int)threadIdx.x & 63;
        tr_load(t, j0, lane);
        for (int it = gw; it < NITEMS; it += NGW) {
            const bool more = it + NGW < NITEMS;
            if (more) { j1 = tr_job<true>(a, it + NGW); tr_load(t2, j1, lane); }
            tr_store(t, j0, scr, lane);
            if (more) { j0 = j1;
#pragma unroll
                for (int i = 0; i < 32; ++i) t[i] = t2[i]; }
        }
    }
    const int gt = F.vcu * (NWAVES * 64) + ((int)threadIdx.x), NGT = F.G * NWAVES * 64;
    { bf16* wf = (bf16*)(ws + WS_WF); const float* src = a.in[I_L0_WIN];
      for (int e = gt; e < 16 * 4096; e += NGT) { const int n = e >> 12, k = e & 4095; wf[e] = (bf16)f2bf(src[(size_t)k * 8208 + 6144 + n] * a.in[I_L0_MIXN][k]); } }
    { bf16* wsg = (bf16*)(ws + WS_WSGU); const float* src = a.in[I_L1_SGUW];
      for (int e = gt; e < 16 * 128 * 128; e += NGT) { const int t = (e >> 7) & 127, s = e & 127; wsg[e] = (s <= t) ? (bf16)f2bf(src[e]) : (bf16)0; } }
    xb_rows(a.in[I_X], (bf16*)(ws + WS_XN), (float*)(ws + WS_SSP), gw, NGW, ((int)threadIdx.x & 63));
}

constexpr int CW_CVQ = 8256;
__device__ __forceinline__ void cv_queue(Frame& F, const Args& a) {
    LAS float* scr = (LAS float*)(F.lds + F.wave * 16384); const int lane = (int)threadIdx.x & 63; gu32* ctl = (gu32*)(a.ws + WS_CTL);
    for (;;) {
        unsigned base = 0; if (lane == 0) base = __hip_atomic_fetch_add(ctl + CW_CVQ, 8u, RLX_AGENT);
        base = (unsigned)__builtin_amdgcn_readfirstlane((int)base);
        if (base >= (unsigned)CV_NITEMS) break;
        const int n = (int)base + 8 <= CV_NITEMS ? 8 : CV_NITEMS - (int)base;
        float t[32], t2[32], t3[32]; TrJob j0 = tr_job<false>(a, (int)base), j1 = j0, j2 = j0;
        tr_load(t, j0, lane);
        if (n > 1) { j1 = tr_job<false>(a, (int)base + 1); tr_load(t2, j1, lane); }
        for (int i = 0; i < n; ++i) {
            if (i + 2 < n) { j2 = tr_job<false>(a, (int)base + i + 2); tr_load(t3, j2, lane); }
            tr_store(t, j0, scr, lane);
            j0 = j1; j1 = j2;
#pragma unroll
            for (int k = 0; k < 32; ++k) { t[k] = t2[k]; t2[k] = t3[k]; } }
    }
}
__device__ __forceinline__ void cv_static(Frame& F, const Args& a, int lo, int n, int wk, int nwk) {
    LAS float* scr = (LAS float*)(F.lds + F.wave * 16384); const int lane = (int)threadIdx.x & 63;
    const int r0 = wk * NWAVES + F.wave, st = nwk * NWAVES;
    if (r0 < n) {
        float t[32], t2[32]; TrJob j0 = tr_job<false>(a, lo + r0), j1 = j0;
        tr_load(t, j0, lane);
        for (int r = r0; r < n; r += st) { const bool more = r + st < n;
            if (more) { j1 = tr_job<false>(a, lo + r + st); tr_load(t2, j1, lane); }
            tr_store(t, j0, scr, lane);
            if (more) { j0 = j1;
#pragma unroll
                for (int i = 0; i < 32; ++i) t[i] = t2[i]; } }
    }
}
__device__ __forceinline__ void convert_w1dn(Frame& F, const Args& a, int wk, int nwk) {
    LAS float* scr = (LAS float*)(F.lds + F.wave * 16384); const int lane = (int)threadIdx.x & 63;
    constexpr int nb = 4096 / 32, nitems = (11008 / 64) * nb; const int r0 = wk * NWAVES + F.wave, st = nwk * NWAVES;
    if (r0 < nitems) {
        float t[32], t2[32]; TrJob j0, j1; j0.gk = nullptr; j0.ld = 4096; j0.K = 11008; j1 = j0;
        j0.src = a.in[I_L1_WDN] + 32 * (r0 % nb); j0.dst = (bf16*)(a.ws + WS_W1DN) + (size_t)(32 * (r0 % nb)) * 11008; j0.k0 = 64 * (r0 / nb);
        tr_load(t, j0, lane);
        for (int r = r0; r < nitems; r += st) { const int rn = r + st; const bool more = rn < nitems;
            if (more) { j1.src = a.in[I_L1_WDN] + 32 * (rn % nb); j1.dst = (bf16*)(a.ws + WS_W1DN) + (size_t)(32 * (rn % nb)) * 11008; j1.k0 = 64 * (rn / nb); tr_load(t2, j1, lane); }
            tr_store(t, j0, scr, lane);
            if (more) { j0 = j1;
#pragma unroll
                for (int i = 0; i < 32; ++i) t[i] = t2[i]; } }
    }
}
__device__ __forceinline__ void p_logits(const Args& a, int gw, int NGW) {
    unsigned char* ws = a.ws; const int lane = (int)threadIdx.x & 63;
    {
        const bf16* XN = (const bf16*)(ws + WS_XN); const bf16* WF = (const bf16*)(ws + WS_WF); float* LF = (float*)(ws + WS_LF);
        for (int grp = gw; grp < SEQ / 16; grp += NGW) {
            const bf16* ap = XN + (size_t)(grp * 16 + (lane & 15)) * DM + (lane >> 4) * 8; const bf16* bp = WF + (size_t)(lane & 15) * DM + (lane >> 4) * 8;
            f32x4 acc = (f32x4){0.f, 0.f, 0.f, 0.f};
#pragma unroll 8
            for (int k0 = 0; k0 < DM; k0 += 32) acc = __builtin_amdgcn_mfma_f32_16x16x32_bf16(*(const bf16x8*)(ap + k0), *(const bf16x8*)(bp + k0), acc, 0, 0, 0);
            const int head = lane & 15; const float bias = a.in[I_L0_BF][head]; const float* ss = (const float*)(ws + WS_SSP);
#pragma unroll
            for (int j = 0; j < 4; ++j) { const float x = acc[j] * (1.0f / sqrtf(ss[grp * 16 + 4 * (lane >> 4) + j] * (1.f / DM) + EPS)) + bias; LF[(size_t)head * SEQ + grp * 16 + 4 * (lane >> 4) + j] = fminf(x, 0.f) - log1pf(__expf(-fabsf(x))); }
        }
    }
}
template <int W> __device__ __forceinline__ void pool_task(unsigned char* ws, int task) {
    const bf16* ZP = (const bf16*)(ws + WS_ZP); bf16* PL = (bf16*)(ws + WS_PL);
    const int strip = task >> 8, q = task & 255, g = q >> 6, t0 = strip * 8;
    v4u z[8 + W - 1];
    const GAS unsigned char* zb = (const GAS unsigned char*)ZP; const int tb = t0 - (W - 1);
#pragma unroll
    for (int i = 0; i < 8 + W - 1; ++i) { const int t = tb + i; const unsigned off = (unsigned)((t < 0 ? 0 : t) * HW + q * 8) * 2u; const v4u v = *(const GAS v4u*)(zb + off); z[i] = t >= 0 ? v : (v4u){0u, 0u, 0u, 0u}; }
    float s[8] = {0.f, 0.f, 0.f, 0.f, 0.f, 0.f, 0.f, 0.f};
#pragma unroll
    for (int i = 0; i < W - 1; ++i) { s[0] += bflo(z[i].x); s[1] += bfhi(z[i].x); s[2] += bflo(z[i].y); s[3] += bfhi(z[i].y); s[4] += bflo(z[i].z); s[5] += bfhi(z[i].z); s[6] += bflo(z[i].w); s[7] += bfhi(z[i].w); }
#pragma unroll
    for (int r = 0; r < 8; ++r) { const v4u zn = z[W - 1 + r]; const int t = t0 + r;
        const float c[8] = {bflo(zn.x), bfhi(zn.x), bflo(zn.y), bfhi(zn.y), bflo(zn.z), bfhi(zn.z), bflo(zn.w), bfhi(zn.w)};
#pragma unroll
        for (int e = 0; e < 8; ++e) s[e] += c[e];
        const float ic = 1.0f / (float)(t + 1 < W ? t + 1 : W);
        v4u o; o.x = pk2(s[0] * ic - c[0], s[1] * ic - c[1]); o.y = pk2(s[2] * ic - c[2], s[3] * ic - c[3]); o.z = pk2(s[4] * ic - c[4], s[5] * ic - c[5]); o.w = pk2(s[6] * ic - c[6], s[7] * ic - c[7]);
        *(GAS v4u*)(PL + ((size_t)g * SEQ + t) * 512 + (q & 63) * 8) = o;
        const v4u zo = z[r];
        s[0] -= bflo(zo.x); s[1] -= bfhi(zo.x); s[2] -= bflo(zo.y); s[3] -= bfhi(zo.y); s[4] -= bflo(zo.z); s[5] -= bfhi(zo.z); s[6] -= bflo(zo.w); s[7] -= bfhi(zo.w); }
}
__device__ __forceinline__ void p2_prep(Frame& F, const Args& a) {
    unsigned char* ws = a.ws;
    const int gw = F.vcu * NWAVES + F.wave, NGW = F.G * NWAVES, lane = ((int)threadIdx.x & 63);
    {
        const int gt = F.vcu * (NWAVES * 64) + ((int)threadIdx.x), NGT = F.G * NWAVES * 64;
        for (int task = gt; task < (SEQ / 8) * 256; task += NGT) {
            const int q = task & 255, g = q >> 6;
            if (g == 0) pool_task<2>(ws, task); else if (g == 1) pool_task<4>(ws, task); else if (g == 2) pool_task<8>(ws, task); else pool_task<16>(ws, task);
        }
    }
}
__device__ __forceinline__ void p3_cumsum(Frame& F, const Args& a, int h) {
    const float* LF = (const float*)(a.ws + WS_LF) + (size_t)h * SEQ; float* T = (float*)(a.ws + WS_T) + (size_t)h * SEQ;
    LAS float* sh = (LAS float*)F.lds;
    float v[16]; float s = 0.f;
#pragma unroll
    for (int j = 0; j < 4; ++j) { const f32x4 x = *(const GAS f32x4*)(LF + ((int)threadIdx.x) * 16 + 4 * j); v[4 * j] = x.x; v[4 * j + 1] = x.y; v[4 * j + 2] = x.z; v[4 * j + 3] = x.w; }
#pragma unroll
    for (int j = 0; j < 16; ++j) { s += v[j]; v[j] = s; }
    float inc = s;
#pragma unroll
    for (int o = 1; o < 64; o <<= 1) { const float t = __shfl_up(inc, o); if (((int)threadIdx.x & 63) >= o) inc += t; }
    if (((int)threadIdx.x & 63) == 63) sh[F.wave] = inc;
    __syncthreads();
    float off = inc - s;
    for (int w = 0; w < F.wave; ++w) off += sh[w];
    const float k = -1.0f / ATT_SCALE;
#pragma unroll
    for (int j = 0; j < 4; ++j) *(GAS f32x4*)(T + ((int)threadIdx.x) * 16 + 4 * j) = (f32x4){(off + v[4 * j]) * k, (off + v[4 * j + 1]) * k, (off + v[4 * j + 2]) * k, (off + v[4 * j + 3]) * k};
    __syncthreads();
}
__device__ __forceinline__ void ffn_act_phase(Frame& F, const bf16* GU, const float* cw, bf16* ACT) {
    const int gt = F.vcu * (NWAVES * 64) + ((int)threadIdx.x), NGT = F.G * NWAVES * 64;
    constexpr int NCH = DFF / 8, NTASK = (SEQ / 16) * NCH;
    for (int task = gt; task < NTASK; task += NGT) {
        const int strip = task / NCH, q = task - strip * NCH, t0 = strip * 16, gcol = (q >> 4) * 256 + (q & 15) * 8;
        float w0[8], w1[8], w2[8], p2[8], p1[8];
#pragma unroll
        for (int i = 0; i < 8; ++i) { w0[i] = cw[q * 8 + i]; w1[i] = cw[DFF + q * 8 + i]; w2[i] = cw[2 * DFF + q * 8 + i]; p2[i] = 0.f; p1[i] = 0.f; }
        if (t0 > 0) { const v4u a2 = *(const GAS v4u*)(GU + (size_t)(t0 - 2) * (2 * DFF) + gcol), a1 = *(const GAS v4u*)(GU + (size_t)(t0 - 1) * (2 * DFF) + gcol);
            p2[0] = bflo(a2.x); p2[1] = bfhi(a2.x); p2[2] = bflo(a2.y); p2[3] = bfhi(a2.y); p2[4] = bflo(a2.z); p2[5] = bfhi(a2.z); p2[6] = bflo(a2.w); p2[7] = bfhi(a2.w);
            p1[0] = bflo(a1.x); p1[1] = bfhi(a1.x); p1[2] = bflo(a1.y); p1[3] = bfhi(a1.y); p1[4] = bflo(a1.z); p1[5] = bfhi(a1.z); p1[6] = bflo(a1.w); p1[7] = bfhi(a1.w); }
#pragma unroll 4
        for (int t = t0; t < t0 + 16; ++t) {
            const v4u gw_ = *(const GAS v4u*)(GU + (size_t)t * (2 * DFF) + gcol), uw = *(const GAS v4u*)(GU + (size_t)t * (2 * DFF) + gcol + 128);
            const float c[8] = {bflo(gw_.x), bfhi(gw_.x), bflo(gw_.y), bfhi(gw_.y), bflo(gw_.z), bfhi(gw_.z), bflo(gw_.w), bfhi(gw_.w)};
            const float uu[8] = {bflo(uw.x), bfhi(uw.x), bflo(uw.y), bfhi(uw.y), bflo(uw.z), bfhi(uw.z), bflo(uw.w), bfhi(uw.w)};
            float o[8];
#pragma unroll
            for (int i = 0; i < 8; ++i) { const float y = w0[i] * p2[i] + w1[i] * p1[i] + w2[i] * c[i]; o[i] = y / (1.f + __expf(-y)) * uu[i]; p2[i] = p1[i]; p1[i] = c[i]; }
            v4u ov; ov.x = pk2(o[0], o[1]); ov.y = pk2(o[2], o[3]); ov.z = pk2(o[4], o[5]); ov.w = pk2(o[6], o[7]);
            *(GAS v4u*)(ACT + (size_t)t * DFF + q * 8) = ov;
        }
    }
}
__device__ __forceinline__ void act_fixup_panel(Frame& F, int pm, const float* HG, const float* HU, const float* cw, bf16* ACT) {
    constexpr int NQ = DFF / 4, NT = 2 * NQ;
    for (int base = (int)threadIdx.x; base < NT; base += 4 * NWAVES * 64) {
        f32x4 g0[4], gm1[4], gm2[4], w0[4], w1[4], w2[4], uu[4]; const f32x4 z = (f32x4){0.f, 0.f, 0.f, 0.f};
#pragma unroll
        for (int k = 0; k < 4; ++k) { const int idx = base + k * NWAVES * 64; const int id2 = idx < NT ? idx : base; const int i = id2 / NQ, c4 = (id2 - i * NQ) * 4;
            g0[k] = *(const GAS f32x4*)(HG + ((size_t)pm * 4 + i) * DFF + c4);
            const int r1 = i == 0 ? (pm - 1) * 4 + 3 : pm * 4, r2 = i == 0 ? (pm - 1) * 4 + 2 : (pm - 1) * 4 + 3;
            gm1[k] = (i == 0 && pm == 0) ? z : *(const GAS f32x4*)(HG + (size_t)(r1 < 0 ? 0 : r1) * DFF + c4);
            gm2[k] = pm == 0 ? z : *(const GAS f32x4*)(HG + (size_t)(r2 < 0 ? 0 : r2) * DFF + c4);
            w0[k] = *(const GAS f32x4*)(cw + c4); w1[k] = *(const GAS f32x4*)(cw + DFF + c4); w2[k] = *(const GAS f32x4*)(cw + 2 * DFF + c4); uu[k] = *(const GAS f32x4*)(HU + ((size_t)pm * 2 + i) * DFF + c4); }
#pragma unroll
        for (int k = 0; k < 4; ++k) { const int idx = base + k * NWAVES * 64; if (idx < NT) { const int i = idx / NQ, c4 = (idx - i * NQ) * 4;
            float o[4];
#pragma unroll
            for (int e = 0; e < 4; ++e) { const float y = w0[k][e] * gm2[k][e] + w1[k][e] * gm1[k][e] + w2[k][e] * g0[k][e]; o[e] = y * __builtin_amdgcn_rcpf(1.0f + __expf(-y)) * uu[k][e]; }
            *(GAS unsigned long long*)(ACT + (size_t)(pm * 256 + i) * DFF + c4) = (unsigned long long)pk2(o[0], o[1]) | ((unsigned long long)pk2(o[2], o[3]) << 32); } }
    }
}
__device__ __forceinline__ void p12_mixers(Frame& F, const Args& a) {
    unsigned char* ws = a.ws;
    const bf16* P1 = (const bf16*)(ws + WS_P1); const bf16* VST = (const bf16*)(ws + WS_VST); const bf16* WSG = (const bf16*)(ws + WS_WSGU); bf16* CC = (bf16*)(ws + WS_CC);
    const int lane = ((int)threadIdx.x & 63);
    for (int unit = F.vcu; unit < 256; unit += F.G) {
        const int n = unit >> 2, hg = unit & 3;
        LAS float* part = (LAS float*)F.lds;
        LAS float* rs = (LAS float*)(F.lds + 16384);
        { const int tc = ((int)threadIdx.x) & 15, cg = ((int)threadIdx.x) >> 4; float s[8] = {0.f, 0.f, 0.f, 0.f, 0.f, 0.f, 0.f, 0.f};
          const bf16* p = VST + (size_t)(cg * 64) * SEQ + n * 128 + tc * 8;
#pragma unroll 16
          for (int c = 0; c < 64; ++c) { const v4u w = *(const GAS v4u*)(p + (size_t)c * SEQ);
              float f; f = bflo(w.x); s[0] += f * f; f = bfhi(w.x); s[1] += f * f; f = bflo(w.y); s[2] += f * f; f = bfhi(w.y); s[3] += f * f;
              f = bflo(w.z); s[4] += f * f; f = bfhi(w.z); s[5] += f * f; f = bflo(w.w); s[6] += f * f; f = bfhi(w.w); s[7] += f * f; }
#pragma unroll
          for (int i = 0; i < 8; ++i) part[cg * 128 + tc * 8 + i] = s[i]; }
        __syncthreads();
        if (((int)threadIdx.x) < 128) { float s = 0.f; for (int c = 0; c < 32; ++c) s += part[c * 128 + ((int)threadIdx.x)]; rs[((int)threadIdx.x)] = 1.0f / sqrtf(s * (1.f / 2048.f) + EPS); }
        __syncthreads();
        const int h = hg * 4 + (F.wave >> 1), th = F.wave & 1, fr = lane & 15, fq = lane >> 4;
        bf16x8 Af[4][4];
#pragma unroll
        for (int mt = 0; mt < 4; ++mt)
#pragma unroll
            for (int ks = 0; ks < 4; ++ks) { const int t = 64 * th + 16 * mt + fr, s0 = 32 * ks + 8 * fq;
                const v4u w = *(const GAS v4u*)(WSG + ((size_t)h * 128 + t) * 128 + s0);
                v4u o; o.x = pk2(bflo(w.x) * rs[s0], bfhi(w.x) * rs[s0 + 1]); o.y = pk2(bflo(w.y) * rs[s0 + 2], bfhi(w.y) * rs[s0 + 3]);
                o.z = pk2(bflo(w.z) * rs[s0 + 4], bfhi(w.z) * rs[s0 + 5]); o.w = pk2(bflo(w.w) * rs[s0 + 6], bfhi(w.w) * rs[s0 + 7]);
                Af[mt][ks] = __builtin_bit_cast(bf16x8, o); }
        const float* sg = a.in[I_L1_SGUN]; const float* sb = a.in[I_L1_SGUB];
        bf16x8 Bn[4];
#pragma unroll
        for (int ks = 0; ks < 4; ++ks) Bn[ks] = *(const bf16x8*)(VST + (size_t)(h * 128 + fr) * SEQ + n * 128 + 32 * ks + 8 * fq);
        typedef unsigned u32x2 __attribute__((ext_vector_type(2)));
        const size_t trow = (size_t)n * 128 + 64 * th + fr;
        float sbv[4];
#pragma unroll
        for (int mt = 0; mt < 4; ++mt) sbv[mt] = sb[h * 128 + 64 * th + 16 * mt + fr];
#pragma unroll 1
        for (int nt = 0; nt < 8; ++nt) {
            const int c4 = h * 128 + 16 * nt + 4 * fq;
            bf16x8 Bf[4];
#pragma unroll
            for (int ks = 0; ks < 4; ++ks) Bf[ks] = Bn[ks];
            if (nt + 1 < 8) {
#pragma unroll
                for (int ks = 0; ks < 4; ++ks) Bn[ks] = *(const bf16x8*)(VST + (size_t)(h * 128 + 16 * (nt + 1) + fr) * SEQ + n * 128 + 32 * ks + 8 * fq); }
            u32x2 uv[4];
#pragma unroll
            for (int mt = 0; mt < 4; ++mt) uv[mt] = *(const GAS u32x2*)(P1 + (trow + 16 * mt) * 8192 + 6144 + c4);
            const f32x4 gc = *(const GAS f32x4*)(sg + c4);
            f32x4 acc[4];
#pragma unroll
            for (int mt = 0; mt < 4; ++mt) { acc[mt] = (f32x4){0.f, 0.f, 0.f, 0.f};
#pragma unroll
                for (int ks = 0; ks < 4; ++ks) acc[mt] = __builtin_amdgcn_mfma_f32_16x16x32_bf16(Bf[ks], Af[mt][ks], acc[mt], 0, 0, 0); }
#pragma unroll
            for (int mt = 0; mt < 4; ++mt) { const f32x4 mx = acc[mt] * gc + sbv[mt];
                u32x2 o; o.x = pk2(bflo(uv[mt].x) * mx[0], bfhi(uv[mt].x) * mx[1]); o.y = pk2(bflo(uv[mt].y) * mx[2], bfhi(uv[mt].y) * mx[3]);
                *(GAS u32x2*)(CC + (trow + 16 * mt) * DM + HW + c4) = o; }
        }
        __syncthreads();
    }
    {
        const int gt = F.vcu * (NWAVES * 64) + ((int)threadIdx.x), NGT = F.G * NWAVES * 64; const float* cw = a.in[I_L1_CONVW];
        const GAS unsigned char* pb = (const GAS unsigned char*)P1;
        for (int task = gt; task < (SEQ / 8) * 256; task += NGT) {
            const int strip = task >> 8, q = task & 255, t0 = strip * 8;
            v4u vv[10], cc[10], bb[8];
#pragma unroll
            for (int i = 0; i < 10; ++i) { const int t = t0 - 2 + i; const unsigned off = (unsigned)((t < 0 ? 0 : t) * 8192 + q * 8) * 2u;
                vv[i] = *(const GAS v4u*)(pb + off); cc[i] = *(const GAS v4u*)(pb + off + 2 * HW * 2);
                if (i >= 2) bb[i - 2] = *(const GAS v4u*)(pb + off + HW * 2); }
            float w0[8], w1[8], w2[8], p2[8], p1[8];
#pragma unroll
            for (int i = 0; i < 8; ++i) { w0[i] = cw[q * 8 + i]; w1[i] = cw[HW + q * 8 + i]; w2[i] = cw[2 * HW + q * 8 + i]; }
            const float hz = t0 > 0 ? 1.f : 0.f;
#define CVX(V, C, o) { o[0] = bflo(V.x) * bflo(C.x); o[1] = bfhi(V.x) * bfhi(C.x); o[2] = bflo(V.y) * bflo(C.y); o[3] = bfhi(V.y) * bfhi(C.y); o[4] = bflo(V.z) * bflo(C.z); o[5] = bfhi(V.z) * bfhi(C.z); o[6] = bflo(V.w) * bflo(C.w); o[7] = bfhi(V.w) * bfhi(C.w); }
            CVX(vv[0], cc[0], p2); CVX(vv[1], cc[1], p1);
#pragma unroll
            for (int i = 0; i < 8; ++i) { p2[i] *= hz; p1[i] *= hz; }
#pragma unroll
            for (int r = 0; r < 8; ++r) { float cur[8]; CVX(vv[r + 2], cc[r + 2], cur);
                const v4u bw = bb[r]; const float gb[8] = {bflo(bw.x), bfhi(bw.x), bflo(bw.y), bfhi(bw.y), bflo(bw.z), bfhi(bw.z), bflo(bw.w), bfhi(bw.w)};
                float o[8];
#pragma unroll
                for (int i = 0; i < 8; ++i) { o[i] = gb[i] * (w0[i] * p2[i] + w1[i] * p1[i] + w2[i] * cur[i]); p2[i] = p1[i]; p1[i] = cur[i]; }
                v4u ov; ov.x = pk2(o[0], o[1]); ov.y = pk2(o[2], o[3]); ov.z = pk2(o[4], o[5]); ov.w = pk2(o[6], o[7]);
                *(GAS v4u*)(CC + (size_t)(t0 + r) * DM + q * 8) = ov; }
#undef CVX
        }
    }
}
constexpr int CW_ATTQ = 8192;
__device__ __forceinline__ void p4_attention(Frame& F, const Args& a, char* lds) {
    unsigned char* ws = a.ws; gu32* ctl = (gu32*)(ws + WS_CTL);
    const fox::bf16* Qb = (const fox::bf16*)(ws + WS_QKV); const fox::bf16* Kb = Qb + (size_t)NH * SEQ * 128; const fox::bf16* Vb = Kb + (size_t)NH * SEQ * 128;
    fox::bf16* CC = (fox::bf16*)(ws + WS_CC); const float* T = (const float*)(ws + WS_T);
    const int tid = (int)threadIdx.x, lane = tid & 63;
    volatile LAS unsigned* qw = (volatile LAS unsigned*)(F.lds + fox::LDS_ATT);
    { float cb; float mq = fmaxf(fabsf(a.in[I_L0_QG][lane]), fabsf(a.in[I_L0_QG][lane + 64])), mk = fmaxf(fabsf(a.in[I_L0_KG][lane]), fabsf(a.in[I_L0_KG][lane + 64]));
#pragma unroll
      for (int o = 1; o < 64; o <<= 1) { mq = fmaxf(mq, __shfl_xor(mq, o)); mk = fmaxf(mk, __shfl_xor(mk, o)); }
      const float bqk = 128.0f * mq * mk * ATT_SCALE * 1.02f; cb = (120.0f + 2.0f * bqk) * (1.0f / ATT_SCALE); if (tid == 0) qw[3] = __builtin_bit_cast(unsigned, cb); }
    for (;;) {
        int tv = (int)threadIdx.x; asm volatile("" : "+v"(tv));
        const int lane_ = tv & 63;
        if (tv == 0) qw[0] = __hip_atomic_fetch_add(ctl + CW_ATTQ, 1u, RLX_AGENT);
        __syncthreads();
        const int item = __builtin_amdgcn_readfirstlane((int)qw[0]);
        if (item >= 2 * 256) break;
        const int h = item & 15, qb = 31 - (item >> 4), P0 = qb * 256, ntf = (P0 + 256) / 64;
        const float* Th = T + (size_t)h * SEQ;
        if (tv < 128) { const float tp0 = Th[P0]; const float cb = __builtin_bit_cast(float, (unsigned)qw[3]); const bool skip = (tv < ntf - 4) && (Th[64 * tv + 63] < tp0 - cb);
            const unsigned long long m = __ballot(skip); if (lane_ == 0) qw[1 + (tv >> 6)] = (unsigned)__popcll(m); }
        __syncthreads();
        const int jlo = __builtin_amdgcn_readfirstlane((int)(qw[1] + qw[2]));
        { const GAS f32x4* src = (const GAS f32x4*)Th; LAS f32x4* dst = (LAS f32x4*)((LAS unsigned char*)F.lds + fox::LDS_T);
          for (int e = jlo * 16 + tv; e < ntf * 16; e += NWAVES * 64) dst[e] = src[e]; }
        fox::BlockRef r; r.Q = Qb + ((size_t)h * SEQ + P0) * 128; r.K = Kb + (size_t)h * SEQ * 128; r.V = Vb + (size_t)h * SEQ * 128; r.O = CC + (size_t)P0 * DM + h * 128; r.P0 = P0; r.jlo = jlo;
        fox::Seam S;
        fox::fox_prime(r, lds, S, tv);
        fox::fox_block(r, r, lds, S, tv);
    }
}
#ifndef MK_N_LAUNCHES
#define MK_N_LAUNCHES 1
#endif
constexpr int NPHASES = 12;
#ifndef GEMM_SP2
#define GEMM_SP2 true
#endif
#ifndef PHM
#define PHM 0xFFFFFFFFu
#endif
#define PM(k) ((PHM >> (k)) & 1u)
__global__ void __launch_bounds__(NWAVES * 64, 2) fwd(Args args) {
    extern __shared__ __attribute__((aligned(16))) unsigned char lds[];
    Frame F;
    F.lds = (LAS unsigned char*)lds;
    F.MISC = (volatile LAS unsigned*)(F.lds + MISC_OFF);
    F.wave = __builtin_amdgcn_readfirstlane((int)threadIdx.x >> 6);
    F.G = gridDim.x; { const int bx = blockIdx.x; F.vcu = (F.G % 8 == 0) ? (bx % 8) * (F.G / 8) + bx / 8 : bx; }
    unsigned char* ws = args.ws;
    gu32* ctl = (gu32*)(ws + WS_CTL);
    for (int u = ((int)threadIdx.x); u < (LDS_BYTES - LDSCTL_OFF) / 4; u += NWAVES * 64) ((LAS unsigned*)(F.lds + LDSCTL_OFF))[u] = 0u;
    __syncthreads();
    const int lo = args.ph_lo, hi = args.ph_hi;
    XcdBarrier bar; bar.bar = (unsigned*)(ctl + CW_BAR); bar.x = 0; bar.st = nullptr;
    if (hi - lo > 1) bar = xcd_barrier_post((unsigned*)(ctl + CW_BAR), F.MISC + 8);
    int ph = 0;
#define PH_ON (ph >= lo && ph < hi)
#define PH_END do { if (ph + 1 < hi) xcd_barrier(bar); } while (0)
#define PAIROK (bar.st != nullptr && bar.st[2] != 0u)
#define PH_END_PAIR do { if (ph + 1 < hi) { if (PAIROK) xcd_barrier_pair(bar); else xcd_barrier(bar); } } while (0)
    bf16* XN = (bf16*)(ws + WS_XN); bf16* CC = (bf16*)(ws + WS_CC); bf16* GU = (bf16*)(ws + WS_GU); bf16* ACT = (bf16*)(ws + WS_ACT);
    float* X = args.out;
    typedef pg8::StaticOrder SO;
#define GEMM_PHASE(EPI, EINIT, AP, BP, MM, NN, KK) do { pg8::Gemm g{AP, BP, MM, NN, KK}; SO S; S.init(MM, NN, F.G, (int)blockIdx.x); EPI E EINIT; pg8::gemm_phase<EPI, SO, true, GEMM_SP2>(F.lds, g, S, E); } while (0)

    if (PM(0) && PH_ON) { p0_prologue(F, args); PH_END; } ++ph;
    if (PM(2) && PH_ON) {
        constexpr int GW0 = 176;
        if (F.G != 256) { p_logits(args, (int)blockIdx.x * NWAVES + F.wave, F.G * NWAVES); cv_queue(F, args); VM_WAIT(); __syncthreads(); GEMM_PHASE(pg8::EpiQKVZ, ({(bf16*)(ws + WS_QKV), (bf16*)(ws + WS_ZP), pg8::RowScale{(const float*)(ws + WS_SSP), 1, (LAS float*)(F.lds + RR_OFF)}, args.in[I_L0_QG], args.in[I_L0_KG], (LAS float*)(F.lds + RED_OFF)}), XN, (const bf16*)(ws + WS_W0IN), SEQ, 8192, DM); }
        else {
            if ((int)blockIdx.x < GW0) { pg8::Gemm g{XN, (const bf16*)(ws + WS_W0IN), SEQ, 8192, DM}; SO S; S.init(SEQ, 8192, GW0, (int)blockIdx.x);
                pg8::EpiQKVZ E{(bf16*)(ws + WS_QKV), (bf16*)(ws + WS_ZP), pg8::RowScale{(const float*)(ws + WS_SSP), 1, (LAS float*)(F.lds + RR_OFF)}, args.in[I_L0_QG], args.in[I_L0_KG], (LAS float*)(F.lds + RED_OFF)};
                pg8::gemm_phase<pg8::EpiQKVZ, SO, true, true>(F.lds, g, S, E); }
            else p_logits(args, ((int)blockIdx.x - GW0) * NWAVES + F.wave, (256 - GW0) * NWAVES);
            cv_queue(F, args);
        }
        PH_END; } ++ph;
    if (PM(3) && PH_ON) { if (F.vcu < NH) p3_cumsum(F, args, F.vcu); p2_prep(F, args); PH_END; } ++ph;
    if (PM(4) && PH_ON) { {
        pg8::Gemm g{(const bf16*)(ws + WS_PL), (const bf16*)(ws + WS_WPOOL), 4 * SEQ, 2048, 512}; pg8::PoolOrder S{F.G, (int)blockIdx.x};
        pg8::EpiPool E{CC, DM, args.in[I_L0_POOLS]};
        pg8::gemm_phase<pg8::EpiPool, pg8::PoolOrder, true, true>(F.lds, g, S, E); }
        }
    if (PM(5) && PH_ON) { p4_attention(F, args, (char*)lds); PH_END; } ++ph;
    if (PM(7) && PH_ON) { GEMM_PHASE(pg8::EpiResB<0>, ({args.in[I_X], nullptr, XN, DM, (float*)(ws + WS_SSP), (LAS float*)(F.lds + RED_OFF)}), CC, (const bf16*)(ws + WS_W0OUT), SEQ, DM, DM);  PH_END_PAIR; } ++ph;
    if (PM(9) && PH_ON) {
        GEMM_PHASE(pg8::EpiAct, ({ACT, args.in[I_L0_FCONV], (float*)(ws + WS_HG), (float*)(ws + WS_HU), (LAS float*)(F.lds + HALO_OFF), pg8::RowScale{(const float*)(ws + WS_SSP), 16, (LAS float*)(F.lds + RR_OFF)}}), XN, (const bf16*)(ws + WS_W0UP), SEQ, 2 * DFF, DM); if (F.G == 256 && blockIdx.x >= 192) cv_static(F, args, CV_NITEMS, CV_TAIL, (int)blockIdx.x - 192, 64); else if (F.G != 256) cv_static(F, args, CV_NITEMS, CV_TAIL, (int)blockIdx.x, F.G);
        PH_END_PAIR; } ++ph;
    if (PM(11) && PH_ON) {
        { SO S; S.init(SEQ, DM, F.G, (int)blockIdx.x); pg8::Unit u; int last = -1;
          for (int i = 0; S.next(i, u); ++i) if (u.pm != last) { if (PAIROK && u.pm > 0 && (u.pm & 7) == 0) xcd_pair_wait(bar, (unsigned)(u.pm >> 3) - 1u, (unsigned)(u.pm >> 3) - 1u, 2u);
              act_fixup_panel(F, u.pm, (const float*)(ws + WS_HG), (const float*)(ws + WS_HU), args.in[I_L0_FCONV], ACT); last = u.pm; }
          VM_WAIT(); __syncthreads(); }
        GEMM_PHASE(pg8::EpiResB<1>, ({nullptr, nullptr, XN, DM, (float*)(ws + WS_SSP), (LAS float*)(F.lds + RED_OFF)}), ACT, (const bf16*)(ws + WS_W0DN), SEQ, DM, DFF);  PH_END_PAIR; } ++ph;
    if (PM(12) && PH_ON) { {
        GEMM_PHASE(pg8::EpiBf16G<2>, ({(bf16*)(ws + WS_P1), 8192, pg8::RowScale{(const float*)(ws + WS_SSP), 16, (LAS float*)(F.lds + RR_OFF)}}), XN, (const bf16*)(ws + WS_W1IN), SEQ, 8192, DM);
        if (PAIROK) xcd_pair_wait(bar, 0u, 3u, 3u);
        GEMM_PHASE(pg8::EpiBf16G<1>, ({(bf16*)(ws + WS_VST), SEQ, pg8::RowScale{(const float*)(ws + WS_SSP), 16, (LAS float*)(F.lds + RR_OFF)}}), (const bf16*)(ws + WS_W1IN) + (size_t)8192 * DM, XN, 2048, SEQ, DM); }

        PH_END;
    } ++ph;
    if (PM(6) && PH_ON) { p12_mixers(F, args); PH_END; } ++ph;
    if (PM(13) && PH_ON) { GEMM_PHASE(pg8::EpiResB<1>, ({nullptr, nullptr, XN, DM, (float*)(ws + WS_SSP), (LAS float*)(F.lds + RED_OFF)}), CC, (const bf16*)(ws + WS_W1OUT), SEQ, DM, DM); PH_END_PAIR; } ++ph;
    if (PM(15) && PH_ON) { GEMM_PHASE(pg8::EpiAct, ({ACT, args.in[I_L1_FCONV], (float*)(ws + WS_HG), (float*)(ws + WS_HU), (LAS float*)(F.lds + HALO_OFF), pg8::RowScale{(const float*)(ws + WS_SSP), 16, (LAS float*)(F.lds + RR_OFF)}}), XN, (const bf16*)(ws + WS_W1UP), SEQ, 2 * DFF, DM); if (F.G == 256 && blockIdx.x >= 192) convert_w1dn(F, args, (int)blockIdx.x - 192, 64); else if (F.G != 256) convert_w1dn(F, args, (int)blockIdx.x, F.G); PH_END; } ++ph;
    if (PM(17) && PH_ON) {
        { SO S; S.init(SEQ, DM, F.G, (int)blockIdx.x); pg8::Unit u; int last = -1;
          for (int i = 0; S.next(i, u); ++i) if (u.pm != last) { act_fixup_panel(F, u.pm, (const float*)(ws + WS_HG), (const float*)(ws + WS_HU), args.in[I_L1_FCONV], ACT); last = u.pm; }
          VM_WAIT(); __syncthreads(); }
        GEMM_PHASE(pg8::EpiResB<2>, ({nullptr, X, XN, DM, nullptr, nullptr}), ACT, (const bf16*)(ws + WS_W1DN), SEQ, DM, DFF); PH_END; } ++ph;
#undef PH_ON
#undef PH_END
#undef PH_END_PAIR
#undef PAIROK
#undef GEMM_PHASE
}

extern "C" void kernel_launch(void* const* d_in, const int* in_sizes, int n_in, void* d_out, int out_size, void* d_ws, size_t ws_size, hipStream_t stream) {
    static int grid = 0;
    if (grid == 0) {
        if (n_in != 24 || in_sizes[0] != SEQ * DM || out_size != SEQ * DM || ws_size < WS_END) { fprintf(stderr, "kernel_launch: unexpected shapes (n_in %d, in0 %d, out %d, ws %zu < %zu); nothing launched\n", n_in, n_in > 0 ? in_sizes[0] : -1, out_size, ws_size, (size_t)WS_END); grid = -1; return; }
        int dev = 0, cus = 0, per_cu = 0;
        if (hipGetDevice(&dev) != hipSuccess || hipDeviceGetAttribute(&cus, hipDeviceAttributeMultiprocessorCount, dev) != hipSuccess) { grid = -1; return; }
        if (hipFuncSetAttribute((const void*)fwd, hipFuncAttributeMaxDynamicSharedMemorySize, LDS_BYTES) != hipSuccess) { fprintf(stderr, "kernel_launch: hipFuncSetAttribute failed\n"); grid = -1; return; }
        if (hipOccupancyMaxActiveBlocksPerMultiprocessor(&per_cu, (const void*)fwd, NWAVES * 64, LDS_BYTES) != hipSuccess || per_cu < 1) { fprintf(stderr, "kernel_launch: occupancy query reports %d blocks per CU\n", per_cu); }
        (void)hipGetLastError();
        grid = cus;
    }
    if (grid < 0) return;
    if (hipMemsetAsync((char*)d_ws + WS_CTL, 0, CTL_ZERO_BYTES, stream) != hipSuccess) return;
    Args a{};
    for (int i = 0; i < 24; ++i) a.in[i] = (const float*)d_in[i];
    a.out = (float*)d_out; a.ws = (unsigned char*)d_ws;
    for (int li = 0; li < MK_N_LAUNCHES; ++li) {
        a.ph_lo = (MK_N_LAUNCHES == 1) ? 0 : li; a.ph_hi = (MK_N_LAUNCHES == 1) ? NPHASES : li + 1;
        hipLaunchKernelGGL(fwd, dim3(grid), dim3(NWAVES * 64), LDS_BYTES, stream, a);
        const hipError_t le = hipPeekAtLastError();
        if (le != hipSuccess) { fprintf(stderr, "kernel_launch: launch %d failed: %s\n", li, hipGetErrorName(le)); break; }
    }
}
```

```cpp
#define MK_N_LAUNCHES 1
#include <hip/hip_runtime.h>
#include <cstdio>
#include <cstdint>
namespace pg8 {
#define PG8_LAS __attribute__((address_space(3)))
typedef unsigned short bf16_t;
typedef short bf16x8 __attribute__((ext_vector_type(8)));
typedef float f32x4 __attribute__((ext_vector_type(4)));
typedef unsigned u32x4 __attribute__((ext_vector_type(4)));
constexpr int BM = 256, BK = 64, HALF = 128, HTB = HALF * BK * 2  , STAGE_BYTES = 8 * HTB, NXCD = 8, WGM = 4;

__host__ __device__ __forceinline__ int lds_byte(int r, int c) { const int st = (r >> 4) * 2 + (c >> 5), rr = r & 15, cc = c & 31, ob = rr * 64 + cc * 2; return st * 1024 + (ob ^ (((ob >> 9) & 1) << 5)); }
__host__ __device__ __forceinline__ void stage_rc(int b, int& R, int& C) { const int st = b / 1024, sb = b % 1024, swz = sb ^ (((sb >> 9) & 1) << 5); R = (st >> 1) * 16 + swz / 64; C = (st & 1) * 32 + (swz % 64) / 2; }
__host__ __device__ __forceinline__ int perm32(int rho) { const int n = rho >> 4, i = rho & 15; return 8 * (i >> 2) + 4 * n + (i & 3); }

struct Unit { int pm, pn; };
struct Gemm { const bf16_t* A; const bf16_t* Bt; int M, N, K; };

struct StaticOrder {
    int nM, nN, nwg, G, c;
    __host__ __device__ __forceinline__ void init(int M, int N, int G_, int c_) { nM = M / BM; nN = N / BM; nwg = nM * nN; G = G_; c = c_; }
    __host__ __device__ __forceinline__ bool next(int i, Unit& u) const {
        const long L = (long)i * G + c; if (L >= nwg) return false;
        int wgid = (int)L; { const int q = nwg / NXCD, r = nwg % NXCD, xcd = wgid % NXCD, off = wgid / NXCD; wgid = (xcd < r ? xcd * (q + 1) : r * (q + 1) + (xcd - r) * q) + off; }
        const int nig = WGM * nN, gid = wgid / nig, fm = gid * WGM, gsz = (nM - fm) < WGM ? (nM - fm) : WGM;
        u.pm = fm + ((wgid % nig) % gsz); u.pn = (wgid % nig) / gsz; return true;
    }
    __device__ __forceinline__ void a_ready(const Unit&) const {}
    __device__ __forceinline__ void done(const Unit&) const {}
};

typedef float cvt_pk_bf16_f2 __attribute__((ext_vector_type(2))); typedef __bf16 cvt_pk_bf16_b2 __attribute__((ext_vector_type(2)));
__device__ __forceinline__ unsigned cvt_pk_bf16(float lo, float hi) { const cvt_pk_bf16_f2 v = {lo, hi}; return __builtin_bit_cast(unsigned, __builtin_convertvector(v, cvt_pk_bf16_b2)); }
typedef float f32x2 __attribute__((ext_vector_type(2)));
__device__ __forceinline__ f32x2 gelu_pk(f32x2 v) {
    const f32x2 av = __builtin_elementwise_abs(v), d = av * 0.2316418882f + 1.0f;
    f32x2 t; t.x = __builtin_amdgcn_rcpf(d.x); t.y = __builtin_amdgcn_rcpf(d.y);
    f32x2 q = t * 0.5307027145f + (-0.7265760135f); q = q * t + 0.7107068705f; q = q * t + (-0.142248368f); q = q * t + 0.127414796f; q = q * t;
    const f32x2 s = (v * v) * (-0.72134752044f);
    f32x2 e; e.x = __builtin_amdgcn_exp2f(s.x); e.y = __builtin_amdgcn_exp2f(s.y);
    const f32x2 m = v * (q * e), r = v - m;
    f32x2 o; o.x = v.x < 0.f ? m.x : r.x; o.y = v.y < 0.f ? m.y : r.y; return o;
}

template <int ACT  > struct EpiBf16 {
    static constexpr bool PERM = true, AFTER_DRAIN = false; static_assert(ACT == 0 || ACT == 1, "EpiBf16: ACT is 0 (none) or 1 (gelu_pk)");
    bf16_t* O; int ldc; const float* bias; int split_cols; size_t split_stride; float scale0;
    __device__ __forceinline__ void operator()(const f32x4 (&acc)[2][2][4][2], const Unit& u, int wr, int wc, int fr, int fq) const {
        const int row0 = u.pm * BM + wr * 64 + fr; int colt = u.pn * BM; bf16_t* base = O;
        float sc = 1.f; if (split_cols) { const int t = colt / split_cols; base += (size_t)t * split_stride; colt -= t * split_cols; if (t == 0) sc = scale0; }
        const int col0 = colt + wc * 32 + 8 * fq, bcol0 = u.pn * BM + wc * 32 + 8 * fq;
        f32x4 bv[2][2];
#pragma unroll
        for (int bj = 0; bj < 2; ++bj)
#pragma unroll
            for (int n = 0; n < 2; ++n) bv[bj][n] = bias ? *(const f32x4*)(bias + bcol0 + bj * HALF + 4 * n) : (f32x4){0.f, 0.f, 0.f, 0.f};
#pragma unroll
        for (int ai = 0; ai < 2; ++ai)
#pragma unroll
            for (int m = 0; m < 4; ++m) { bf16_t* rowp = base + (size_t)(row0 + ai * HALF + m * 16) * ldc + col0;
#pragma unroll
                for (int bj = 0; bj < 2; ++bj) { f32x4 v0 = acc[ai][bj][m][0] + bv[bj][0], v1 = acc[ai][bj][m][1] + bv[bj][1];
                    if (ACT == 1) { f32x2 a = gelu_pk((f32x2){v0[0], v0[1]}), b = gelu_pk((f32x2){v0[2], v0[3]}), c = gelu_pk((f32x2){v1[0], v1[1]}), d = gelu_pk((f32x2){v1[2], v1[3]});
                        v0 = (f32x4){a.x, a.y, b.x, b.y}; v1 = (f32x4){c.x, c.y, d.x, d.y}; }
                    v0 = v0 * sc; v1 = v1 * sc; u32x4 w; w.x = cvt_pk_bf16(v0[0], v0[1]); w.y = cvt_pk_bf16(v0[2], v0[3]); w.z = cvt_pk_bf16(v1[0], v1[1]); w.w = cvt_pk_bf16(v1[2], v1[3]);
                    *(u32x4*)(rowp + bj * HALF) = w; } }
    }
};
template <class Epi, class Sched, bool ALIGN_EPI = false, bool SP2 = false>
__device__ __forceinline__ void gemm_phase(PG8_LAS unsigned char* lds, const Gemm g, const Sched& S, const Epi& E) {
    const int tid = threadIdx.x, wid = __builtin_amdgcn_readfirstlane(tid >> 6), lane = tid & 63, wr = wid >> 2, wc = wid & 3, fr = lane & 15, fq = lane >> 4;
    const int K = g.K, nt = K / BK;
    unsigned voffA[2], voffB[2];
#pragma unroll
    for (int i = 0; i < 2; ++i) { int R, C; stage_rc(tid * 16 + i * 8192, R, C); const int Rb = Epi::PERM ? ((R & ~31) + perm32(R & 31)) : R;
        voffA[i] = (unsigned)(R * K + C) * 2u; voffB[i] = (unsigned)(Rb * K + C) * 2u; }
    const size_t kstep = (size_t)(BK * 2);
    const size_t hstep = (size_t)HALF * K * 2;
    const size_t tstep = 2 * hstep;
    const unsigned ldsw = (unsigned)wid * 1024u;
    const int aoff = lds_byte(wr * 64 + fr, fq * 8), boff = lds_byte(wc * 32 + fr, fq * 8);
#define PG8_SA(b, h) (((b) * 2 + (h)) * HTB)
#define PG8_SB(b, h) ((4 + (b) * 2 + (h)) * HTB)
#define PG8_STAGE(bufoff, gbase, voff) do { _Pragma("unroll") for (int _i = 0; _i < 2; ++_i) \
        __builtin_amdgcn_global_load_lds((const unsigned*)((const char*)(gbase) + (voff)[_i]), (PG8_LAS unsigned*)(lds + (bufoff) + ldsw + _i * 8192), 16, 0, 0); } while (0)
#define PG8_LDA(dst, b, h) do { _Pragma("unroll") for (int m = 0; m < 4; ++m) _Pragma("unroll") for (int k = 0; k < 2; ++k) dst[m][k] = *(const PG8_LAS bf16x8*)(lds + PG8_SA(b, h) + aoff + m * 2048 + k * 1024); } while (0)
#define PG8_LDB(dst, b, h) do { _Pragma("unroll") for (int n = 0; n < 2; ++n) _Pragma("unroll") for (int k = 0; k < 2; ++k) dst[n][k] = *(const PG8_LAS bf16x8*)(lds + PG8_SB(b, h) + boff + n * 2048 + k * 1024); } while (0)
#define PG8_MMA(ai, bj, At, Bt) do { __builtin_amdgcn_s_setprio(1); _Pragma("unroll") for (int m = 0; m < 4; ++m) _Pragma("unroll") for (int n = 0; n < 2; ++n) _Pragma("unroll") for (int k = 0; k < 2; ++k) \
        acc[ai][bj][m][n] = __builtin_amdgcn_mfma_f32_16x16x32_bf16(Bt[n][k], At[m][k], acc[ai][bj][m][n], 0, 0, 0); __builtin_amdgcn_s_setprio(0); } while (0)
#define PG8_WAIT_V(n) asm volatile("s_waitcnt vmcnt(" #n ")" ::: "memory")
#define PG8_WAIT_L(n) asm volatile("s_waitcnt lgkmcnt(" #n ")" ::: "memory")
#define PG8_BAR __builtin_amdgcn_s_barrier()
#define PG8_SCHED __builtin_amdgcn_sched_barrier(0)
    Unit cur, nxt; int ui = 0;
    if (!S.next(0, cur)) return;
    f32x4 acc[2][2][4][2];
#pragma unroll
    for (int a = 0; a < 2; ++a)
#pragma unroll
        for (int b = 0; b < 2; ++b)
#pragma unroll
            for (int m = 0; m < 4; ++m)
#pragma unroll
                for (int n = 0; n < 2; ++n) acc[a][b][m][n] = (f32x4){0.f, 0.f, 0.f, 0.f};
    bf16x8 At[4][2], B0[2][2], B1[2][2];
    const char* cA = (const char*)g.A + (size_t)cur.pm * tstep; const char* cB = (const char*)g.Bt + (size_t)cur.pn * tstep;
    S.a_ready(cur);
    if constexpr (SP2) {
        PG8_STAGE(PG8_SB(0, 0), cB, voffB); PG8_STAGE(PG8_SB(0, 1), cB + hstep, voffB); PG8_STAGE(PG8_SA(0, 0), cA, voffA); PG8_STAGE(PG8_SA(0, 1), cA + hstep, voffA);
        if (wr == 1) PG8_BAR;
        PG8_WAIT_V(2); PG8_BAR;
        PG8_STAGE(PG8_SB(1, 0), cB + kstep, voffB); PG8_STAGE(PG8_SA(1, 0), cA + kstep, voffA); PG8_STAGE(PG8_SB(1, 1), cB + hstep + kstep, voffB);
        PG8_WAIT_V(6); PG8_BAR;
    } else {
        PG8_STAGE(PG8_SB(0, 0), cB, voffB); PG8_STAGE(PG8_SA(0, 0), cA, voffA); PG8_STAGE(PG8_SB(0, 1), cB + hstep, voffB); PG8_STAGE(PG8_SA(0, 1), cA + hstep, voffA);
        if (wr == 1) PG8_BAR;
        PG8_WAIT_V(4); PG8_BAR;
        PG8_STAGE(PG8_SB(1, 0), cB + kstep, voffB); PG8_STAGE(PG8_SA(1, 0), cA + kstep, voffA); PG8_STAGE(PG8_SB(1, 1), cB + hstep + kstep, voffB);
        PG8_WAIT_V(6); PG8_BAR;
    }
    for (;;) {
        const bool has_next = S.next(ui + 1, nxt);
        const char* nA = has_next ? (const char*)g.A + (size_t)nxt.pm * tstep : cA; const char* nB = has_next ? (const char*)g.Bt + (size_t)nxt.pn * tstep : cB;
        for (int t = 0; t < nt; t += 2) {
            const bool last = (t == nt - 2);
            const char* a1 = cA + (size_t)(t + 1) * kstep;
            const char* a2 = last ? nA : cA + (size_t)(t + 2) * kstep; const char* b2 = last ? nB : cB + (size_t)(t + 2) * kstep;
            const char* a3 = a2 + kstep; const char* b3 = b2 + kstep;
            if (last && has_next) S.a_ready(nxt);
            if constexpr (SP2) {
            PG8_LDB(B0, 0, 0); PG8_LDB(B1, 0, 1); PG8_SCHED; PG8_LDA(At, 0, 0); PG8_STAGE(PG8_SA(1, 1), a1 + hstep, voffA);
            PG8_WAIT_V(8); PG8_WAIT_L(0); PG8_BAR; PG8_MMA(0, 0, At, B0); PG8_MMA(0, 1, At, B1); PG8_BAR; PG8_SCHED;
            PG8_LDA(At, 0, 1); PG8_STAGE(PG8_SB(0, 0), b2, voffB); PG8_STAGE(PG8_SB(0, 1), b2 + hstep, voffB); PG8_STAGE(PG8_SA(0, 0), a2, voffA);
            PG8_WAIT_V(8); PG8_WAIT_L(0); PG8_BAR; PG8_MMA(1, 0, At, B0); PG8_MMA(1, 1, At, B1); PG8_BAR; PG8_SCHED;
            PG8_LDB(B0, 1, 0); PG8_LDB(B1, 1, 1); PG8_SCHED; PG8_LDA(At, 1, 0); PG8_STAGE(PG8_SA(0, 1), a2 + hstep, voffA);
            PG8_WAIT_V(8); PG8_WAIT_L(0); PG8_BAR; PG8_MMA(0, 0, At, B0); PG8_MMA(0, 1, At, B1); PG8_BAR; PG8_SCHED;
            PG8_LDA(At, 1, 1); PG8_STAGE(PG8_SB(1, 0), b3, voffB); PG8_STAGE(PG8_SB(1, 1), b3 + hstep, voffB); PG8_STAGE(PG8_SA(1, 0), a3, voffA);
            PG8_WAIT_V(8); PG8_WAIT_L(0); PG8_BAR; PG8_MMA(1, 0, At, B0); PG8_MMA(1, 1, At, B1); PG8_BAR; PG8_SCHED;
            } else {
            PG8_LDB(B0, 0, 0); PG8_SCHED; PG8_LDA(At, 0, 0); PG8_STAGE(PG8_SA(1, 1), a1 + hstep, voffA);
            PG8_WAIT_L(8); PG8_BAR; PG8_WAIT_L(0); PG8_MMA(0, 0, At, B0); PG8_BAR; PG8_SCHED;
            PG8_LDB(B1, 0, 1); PG8_STAGE(PG8_SB(0, 0), b2, voffB);
            PG8_BAR; PG8_WAIT_L(0); PG8_MMA(0, 1, At, B1); PG8_BAR;
            PG8_LDA(At, 0, 1); PG8_STAGE(PG8_SA(0, 0), a2, voffA);
            PG8_BAR; PG8_WAIT_L(0); PG8_MMA(1, 0, At, B0); PG8_BAR; PG8_SCHED;
            PG8_STAGE(PG8_SB(0, 1), b2 + hstep, voffB);
            PG8_WAIT_V(6); PG8_BAR; PG8_MMA(1, 1, At, B1); PG8_BAR;
            PG8_LDB(B0, 1, 0); PG8_SCHED; PG8_LDA(At, 1, 0); PG8_STAGE(PG8_SA(0, 1), a2 + hstep, voffA);
            PG8_WAIT_L(8); PG8_BAR; PG8_WAIT_L(0); PG8_MMA(0, 0, At, B0); PG8_BAR; PG8_SCHED;
            PG8_LDB(B1, 1, 1); PG8_STAGE(PG8_SB(1, 0), b3, voffB);
            PG8_BAR; PG8_WAIT_L(0); PG8_MMA(0, 1, At, B1); PG8_BAR;
            PG8_LDA(At, 1, 1); PG8_STAGE(PG8_SA(1, 0), a3, voffA);
            PG8_BAR; PG8_WAIT_L(0); PG8_MMA(1, 0, At, B0); PG8_BAR; PG8_SCHED;
            PG8_STAGE(PG8_SB(1, 1), b3 + hstep, voffB);
            PG8_WAIT_V(6); PG8_BAR; PG8_MMA(1, 1, At, B1); PG8_BAR;
            }
        }
        if constexpr (ALIGN_EPI) { if (wr == 0) PG8_BAR; }
        if constexpr (!Epi::AFTER_DRAIN) { E(acc, cur, wr, wc, fr, fq); S.done(cur); }
        if (!has_next) break;
#pragma unroll
        for (int a = 0; a < 2; ++a)
#pragma unroll
            for (int b = 0; b < 2; ++b)
#pragma unroll
                for (int m = 0; m < 4; ++m)
#pragma unroll
                    for (int n = 0; n < 2; ++n) acc[a][b][m][n] = (f32x4){0.f, 0.f, 0.f, 0.f};
        cur = nxt; cA = nA; cB = nB; ++ui;
        if constexpr (ALIGN_EPI) { if (wr == 1) PG8_BAR; }
    }
    PG8_WAIT_V(0);
    if constexpr (!ALIGN_EPI) { if (wr == 0) PG8_BAR; }
    PG8_BAR;
    if constexpr (Epi::AFTER_DRAIN) { E.fused(acc, cur, wr, wc, fr, fq, lds, wid, lane); S.done(cur); }
#undef PG8_SA
#undef PG8_SB
#undef PG8_STAGE
#undef PG8_LDA
#undef PG8_LDB
#undef PG8_MMA
#undef PG8_WAIT_V
#undef PG8_WAIT_L
#undef PG8_BAR
#undef PG8_SCHED
}

struct RowScale {
    const float* ssp; int nparts; PG8_LAS float* rr; mutable int last = -1;
    __device__ __forceinline__ bool need(int row0) const { return last != row0; }
    __device__ __forceinline__ void fill(int row0, int tid) const {
        last = row0;
        if (tid < 256) { float v[16];
#pragma unroll
            for (int p = 0; p < 16; ++p) v[p] = p < nparts ? ssp[(size_t)p * 8192 + row0 + tid] : 0.f;
            const float s = (((v[0] + v[1]) + (v[2] + v[3])) + ((v[4] + v[5]) + (v[6] + v[7]))) + (((v[8] + v[9]) + (v[10] + v[11])) + ((v[12] + v[13]) + (v[14] + v[15])));
            rr[tid] = 1.0f / sqrtf(s * (1.0f / 4096.0f) + 1e-6f); }
    }
    __device__ __forceinline__ void sync() const { asm volatile("s_waitcnt lgkmcnt(0)" ::: "memory"); __builtin_amdgcn_s_barrier(); asm volatile("" ::: "memory"); }
};
struct EpiQKVZ {
    static constexpr bool PERM = true, AFTER_DRAIN = false;
    bf16_t* QKV; bf16_t* ZP; RowScale rs; const float* qg; const float* kg; PG8_LAS float* hn;
    __device__ __forceinline__ void store(const f32x4 (&acc)[2][2][4][2], bf16_t* base0, size_t bjstep, int ld, const PG8_LAS float* rl) const {
#pragma unroll
        for (int ai = 0; ai < 2; ++ai)
#pragma unroll
            for (int m = 0; m < 4; ++m) { bf16_t* rowp = base0 + (size_t)(ai * HALF + m * 16) * ld; const float r = rl[ai * HALF + m * 16];
#pragma unroll
                for (int bj = 0; bj < 2; ++bj) { const f32x4 v0 = acc[ai][bj][m][0] * r, v1 = acc[ai][bj][m][1] * r;
                    u32x4 w; w.x = cvt_pk_bf16(v0[0], v0[1]); w.y = cvt_pk_bf16(v0[2], v0[3]); w.z = cvt_pk_bf16(v1[0], v1[1]); w.w = cvt_pk_bf16(v1[2], v1[3]);
                    *(u32x4*)(rowp + bj * bjstep) = w; } }
    }
    __device__ __forceinline__ void operator()(const f32x4 (&acc)[2][2][4][2], const Unit& u, int wr, int wc, int fr, int fq) const {
        const int row0 = u.pm * BM + wr * 64 + fr, cl = wc * 32 + 8 * fq;
        if (rs.need(u.pm * BM)) { rs.fill(u.pm * BM, (wr * 4 + wc) * 64 + fq * 16 + fr); rs.sync(); }
        const PG8_LAS float* rl = rs.rr + wr * 64 + fr;
        if (u.pn < 16) {
#pragma unroll
            for (int ai = 0; ai < 2; ++ai)
#pragma unroll
                for (int m = 0; m < 4; ++m) { const float r = rl[ai * HALF + m * 16];
#pragma unroll
                    for (int bj = 0; bj < 2; ++bj) { const f32x4 a0 = acc[ai][bj][m][0] * r, a1 = acc[ai][bj][m][1] * r;
                        float sq = ((a0[0] * a0[0] + a0[1] * a0[1]) + (a0[2] * a0[2] + a0[3] * a0[3])) + ((a1[0] * a1[0] + a1[1] * a1[1]) + (a1[2] * a1[2] + a1[3] * a1[3]));
                        sq += __shfl_xor(sq, 16); sq += __shfl_xor(sq, 32);
                        if (fq == 0) hn[((ai * HALF + wr * 64 + m * 16 + fr) * 2 + bj) * 4 + wc] = sq; } }
            asm volatile("s_waitcnt lgkmcnt(0)" ::: "memory"); __builtin_amdgcn_s_barrier(); asm volatile("" ::: "memory");
            const float* gp = (u.pn < 8 ? qg : kg) + cl; const f32x4 g0 = *(const f32x4*)gp, g1 = *(const f32x4*)(gp + 4);
            bf16_t* base0 = QKV + (size_t)(u.pn * 2) * 8192 * 128 + (size_t)row0 * 128 + cl;
#pragma unroll
            for (int ai = 0; ai < 2; ++ai)
#pragma unroll
                for (int m = 0; m < 4; ++m) { const int rw = ai * HALF + wr * 64 + m * 16 + fr; const float r = rl[ai * HALF + m * 16];
#pragma unroll
                    for (int bj = 0; bj < 2; ++bj) { const f32x4 p = *(const PG8_LAS f32x4*)(hn + (rw * 2 + bj) * 4);
                        const float sc = r * __builtin_amdgcn_rsqf(((p[0] + p[1]) + (p[2] + p[3])) * (1.0f / 128.0f) + 1e-6f);
                        const f32x4 v0 = acc[ai][bj][m][0] * sc * g0, v1 = acc[ai][bj][m][1] * sc * g1;
                        u32x4 w; w.x = cvt_pk_bf16(v0[0], v0[1]); w.y = cvt_pk_bf16(v0[2], v0[3]); w.z = cvt_pk_bf16(v1[0], v1[1]); w.w = cvt_pk_bf16(v1[2], v1[3]);
                        *(u32x4*)(base0 + (size_t)(ai * HALF + m * 16) * 128 + bj * ((size_t)8192 * 128)) = w; } }
        }
        else if (u.pn < 24) store(acc, QKV + (size_t)(u.pn * 2) * 8192 * 128 + (size_t)row0 * 128 + cl, (size_t)8192 * 128, 128, rl);
        else store(acc, ZP + (size_t)row0 * 2048 + (u.pn - 24) * 256 + cl, (size_t)128, 2048, rl);
    }
};
template <int MODE  > struct EpiBf16G {
    static constexpr bool PERM = true, AFTER_DRAIN = false;
    bf16_t* O; int ldc; RowScale rs;
    template <bool G> __device__ __forceinline__ void body(const f32x4 (&acc)[2][2][4][2], bf16_t* base, const PG8_LAS float* rl) const {
        f32x4 cs[2][2];
        if (MODE == 1) {
#pragma unroll
            for (int bj = 0; bj < 2; ++bj) { cs[bj][0] = *(const PG8_LAS f32x4*)(rl + bj * HALF); cs[bj][1] = *(const PG8_LAS f32x4*)(rl + bj * HALF + 4); } }
#pragma unroll
        for (int ai = 0; ai < 2; ++ai)
#pragma unroll
            for (int m = 0; m < 4; ++m) { bf16_t* rowp = base + (size_t)(ai * HALF + m * 16) * ldc; const float r = MODE == 1 ? 1.f : rl[ai * HALF + m * 16];
#pragma unroll
                for (int bj = 0; bj < 2; ++bj) { f32x4 v0, v1;
                    if (MODE == 1) { v0 = acc[ai][bj][m][0] * cs[bj][0]; v1 = acc[ai][bj][m][1] * cs[bj][1]; } else { v0 = acc[ai][bj][m][0] * r; v1 = acc[ai][bj][m][1] * r; }
                    if (G) { f32x2 a = gelu_pk((f32x2){v0[0], v0[1]}), b = gelu_pk((f32x2){v0[2], v0[3]}), c = gelu_pk((f32x2){v1[0], v1[1]}), d = gelu_pk((f32x2){v1[2], v1[3]});
                        v0 = (f32x4){a.x, a.y, b.x, b.y}; v1 = (f32x4){c.x, c.y, d.x, d.y}; }
                    u32x4 w; w.x = cvt_pk_bf16(v0[0], v0[1]); w.y = cvt_pk_bf16(v0[2], v0[3]); w.z = cvt_pk_bf16(v1[0], v1[1]); w.w = cvt_pk_bf16(v1[2], v1[3]);
                    *(u32x4*)(rowp + bj * HALF) = w; } }
    }
    __device__ __forceinline__ void operator()(const f32x4 (&acc)[2][2][4][2], const Unit& u, int wr, int wc, int fr, int fq) const {
        bf16_t* base = O + (size_t)(u.pm * BM + wr * 64 + fr) * ldc + u.pn * BM + wc * 32 + 8 * fq;
        if (rs.need((MODE == 1 ? u.pn : u.pm) * BM)) { rs.fill((MODE == 1 ? u.pn : u.pm) * BM, (wr * 4 + wc) * 64 + fq * 16 + fr); rs.sync(); }
        const PG8_LAS float* rl = MODE == 1 ? rs.rr + wc * 32 + 8 * fq : rs.rr + wr * 64 + fr;
        if (MODE == 1 || (MODE == 2 && u.pn >= 24)) body<true>(acc, base, rl); else body<false>(acc, base, rl);
    }
};
template <int MODE> struct EpiResB {
    static constexpr bool PERM = true, AFTER_DRAIN = false;
    const float* xin; float* out; bf16_t* XB; int ldc; float* ssp; PG8_LAS float* red;
    __device__ __forceinline__ void load2(f32x4 (&b)[2][2][2], size_t off0) const {
#pragma unroll
        for (int mm = 0; mm < 2; ++mm) { const size_t off = off0 + (size_t)(mm * 16) * ldc;
            if (MODE == 0) {
#pragma unroll
                for (int bj = 0; bj < 2; ++bj) { b[mm][bj][0] = *(const f32x4*)(xin + off + bj * HALF); b[mm][bj][1] = *(const f32x4*)(xin + off + bj * HALF + 4); }
            } else {
#pragma unroll
                for (int bj = 0; bj < 2; ++bj) { const u32x4 w = *(const u32x4*)(XB + off + bj * HALF);
                    b[mm][bj][0] = (f32x4){__builtin_bit_cast(float, w.x << 16), __builtin_bit_cast(float, w.x & 0xffff0000u), __builtin_bit_cast(float, w.y << 16), __builtin_bit_cast(float, w.y & 0xffff0000u)};
                    b[mm][bj][1] = (f32x4){__builtin_bit_cast(float, w.z << 16), __builtin_bit_cast(float, w.z & 0xffff0000u), __builtin_bit_cast(float, w.w << 16), __builtin_bit_cast(float, w.w & 0xffff0000u)}; }
            } }
    }
    __device__ __forceinline__ void operator()(const f32x4 (&acc)[2][2][4][2], const Unit& u, int wr, int wc, int fr, int fq) const {
        const int row0 = u.pm * BM + wr * 64 + fr, col0 = u.pn * BM + wc * 32 + 8 * fq;
        const size_t base = (size_t)row0 * ldc + col0;
        f32x4 bc[2][2][2], bn[2][2][2];
        load2(bc, base);
#pragma unroll
        for (int k = 0; k < 4; ++k) { const int ai = k >> 1, m0 = (k & 1) * 2;
            if (k < 3) load2(bn, base + (size_t)(((k + 1) >> 1) * HALF + ((k + 1) & 1) * 32) * ldc);
#pragma unroll
            for (int mm = 0; mm < 2; ++mm) { const int m = m0 + mm; const size_t off = base + (size_t)(ai * HALF + m * 16) * ldc; float s = 0.f;
#pragma unroll
                for (int bj = 0; bj < 2; ++bj) { const f32x4 v0 = bc[mm][bj][0] + acc[ai][bj][m][0], v1 = bc[mm][bj][1] + acc[ai][bj][m][1];
                    if (MODE == 2) { *(f32x4*)(out + off + bj * HALF) = v0; *(f32x4*)(out + off + bj * HALF + 4) = v1; }
                    else { s += ((v0[0] * v0[0] + v0[1] * v0[1]) + (v0[2] * v0[2] + v0[3] * v0[3])) + ((v1[0] * v1[0] + v1[1] * v1[1]) + (v1[2] * v1[2] + v1[3] * v1[3]));
                        u32x4 w; w.x = cvt_pk_bf16(v0[0], v0[1]); w.y = cvt_pk_bf16(v0[2], v0[3]); w.z = cvt_pk_bf16(v1[0], v1[1]); w.w = cvt_pk_bf16(v1[2], v1[3]);
                        *(u32x4*)(XB + off + bj * HALF) = w; } }
                if (MODE != 2) { s += __shfl_xor(s, 16); s += __shfl_xor(s, 32);
                    if (fq == 0) red[wc * 256 + ai * HALF + wr * 64 + m * 16 + fr] = s; } }
            if (k < 3) {
#pragma unroll
                for (int mm = 0; mm < 2; ++mm)
#pragma unroll
                    for (int bj = 0; bj < 2; ++bj) { bc[mm][bj][0] = bn[mm][bj][0]; bc[mm][bj][1] = bn[mm][bj][1]; } }
        }
        if (MODE != 2) {
            asm volatile("s_waitcnt lgkmcnt(0)" ::: "memory"); __builtin_amdgcn_s_barrier(); asm volatile("" ::: "memory");
            const int tid = (wr * 4 + wc) * 64 + fq * 16 + fr;
            if (tid < 256) ssp[(size_t)u.pn * 8192 + u.pm * BM + tid] = (red[tid] + red[256 + tid]) + (red[512 + tid] + red[768 + tid]);
        }
    }
};
struct EpiPool {
    static constexpr bool PERM = true, AFTER_DRAIN = false;
    bf16_t* O; int ldc; const float* scale;
    __device__ __forceinline__ void operator()(const f32x4 (&acc)[2][2][4][2], const Unit& u, int wr, int wc, int fr, int fq) const {
        const int row0 = (u.pm & 31) * BM + wr * 64 + fr, col0 = u.pn * BM + wc * 32 + 8 * fq;
#pragma unroll
        for (int bj = 0; bj < 2; ++bj) { const f32x4 s0 = *(const f32x4*)(scale + col0 + bj * HALF), s1 = *(const f32x4*)(scale + col0 + bj * HALF + 4);
#pragma unroll
            for (int ai = 0; ai < 2; ++ai)
#pragma unroll
                for (int m = 0; m < 4; ++m) { const f32x4 v0 = acc[ai][bj][m][0] * s0, v1 = acc[ai][bj][m][1] * s1;
                    u32x4 w; w.x = cvt_pk_bf16(v0[0], v0[1]); w.y = cvt_pk_bf16(v0[2], v0[3]); w.z = cvt_pk_bf16(v1[0], v1[1]); w.w = cvt_pk_bf16(v1[2], v1[3]);
                    *(u32x4*)(O + (size_t)(row0 + ai * HALF + m * 16) * ldc + 2048 + col0 + bj * HALF) = w; } }
    }
};
struct PoolOrder {
    int G, c;
    __device__ __forceinline__ bool next(int i, Unit& u) const { const int L = i * G + c; if (L >= 256) return false; const int g = L >> 6, r = L & 63; u.pm = 32 * g + (r >> 1); u.pn = 2 * g + (r & 1); return true; }
    __device__ __forceinline__ void a_ready(const Unit&) const {}
    __device__ __forceinline__ void done(const Unit&) const {}
};

__device__ __forceinline__ float dpp_shr1(float old, float src) { return __builtin_bit_cast(float, __builtin_amdgcn_update_dpp(__builtin_bit_cast(int, old), __builtin_bit_cast(int, src), 0x111, 0xF, 0xF, false)); }
__device__ __forceinline__ float dpp_shr2(float old, float src) { return __builtin_bit_cast(float, __builtin_amdgcn_update_dpp(__builtin_bit_cast(int, old), __builtin_bit_cast(int, src), 0x112, 0xF, 0xF, false)); }
__device__ __forceinline__ float dpp_ror1(float src) { return __builtin_bit_cast(float, __builtin_amdgcn_update_dpp(0, __builtin_bit_cast(int, src), 0x121, 0xF, 0xF, false)); }
__device__ __forceinline__ float dpp_ror2(float src) { return __builtin_bit_cast(float, __builtin_amdgcn_update_dpp(0, __builtin_bit_cast(int, src), 0x122, 0xF, 0xF, false)); }
__device__ __forceinline__ float dppz_shr1(float src) { return __builtin_bit_cast(float, __builtin_amdgcn_update_dpp(0, __builtin_bit_cast(int, src), 0x111, 0xF, 0xF, true)); }
__device__ __forceinline__ float dppz_shr2(float src) { return __builtin_bit_cast(float, __builtin_amdgcn_update_dpp(0, __builtin_bit_cast(int, src), 0x112, 0xF, 0xF, true)); }
__device__ __forceinline__ float dppz_ror1(float src) { return __builtin_bit_cast(float, __builtin_amdgcn_update_dpp(0, __builtin_bit_cast(int, src), 0x121, 0xF, 0xF, true)); }
__device__ __forceinline__ float dppz_ror2(float src) { return __builtin_bit_cast(float, __builtin_amdgcn_update_dpp(0, __builtin_bit_cast(int, src), 0x122, 0xF, 0xF, true)); }
struct EpiAct {
    static constexpr bool PERM = true, AFTER_DRAIN = false;
    bf16_t* ACT; const float* cw; float* HG; float* HU; PG8_LAS float* halo; RowScale rs;
    static constexpr int NF = 11008;
    __device__ __forceinline__ void operator()(const f32x4 (&acc)[2][2][4][2], const Unit& u, int wr, int wc, int fr, int fq) const {
        const int cc = wc * 32 + 8 * fq, col = u.pn * 128 + cc;
        f32x4 wq[2][3];
#pragma unroll
        for (int n = 0; n < 2; ++n) { wq[n][0] = *(const f32x4*)(cw + col + 4 * n); wq[n][1] = *(const f32x4*)(cw + NF + col + 4 * n); wq[n][2] = *(const f32x4*)(cw + 2 * NF + col + 4 * n); }
        if (rs.need(u.pm * BM)) rs.fill(u.pm * BM, (wr * 4 + wc) * 64 + fq * 16 + fr);
#pragma unroll
        for (int ai = 0; ai < 2; ++ai) if (fr >= 14) { PG8_LAS float* h = halo + ((2 * ai + wr) * 2 + (fr - 14)) * 128 + cc;
            *(PG8_LAS f32x4*)h = acc[ai][0][3][0]; *(PG8_LAS f32x4*)(h + 4) = acc[ai][0][3][1]; }
        asm volatile("s_waitcnt lgkmcnt(0)" ::: "memory"); __builtin_amdgcn_s_barrier(); asm volatile("" ::: "memory");
        const PG8_LAS float* rl = rs.rr + wr * 64 + fr;
        if (wr == 1 && fr >= 14) { const float r = rl[HALF + 48]; float* g = HG + ((size_t)u.pm * 4 + 2 + (fr - 14)) * NF + col; *(f32x4*)g = acc[1][0][3][0] * r; *(f32x4*)(g + 4) = acc[1][0][3][1] * r; }
        if (wr == 0 && fr < 2) { const float r = rl[0]; float* g = HG + ((size_t)u.pm * 4 + fr) * NF + col; *(f32x4*)g = acc[0][0][0][0] * r; *(f32x4*)(g + 4) = acc[0][0][0][1] * r;
            float* uu = HU + ((size_t)u.pm * 2 + fr) * NF + col; *(f32x4*)uu = acc[0][1][0][0] * r; *(f32x4*)(uu + 4) = acc[0][1][0][1] * r; }
        typedef unsigned u32x2 __attribute__((ext_vector_type(2)));
        const float m0 = fr == 0 ? 1.f : 0.f, m01 = fr < 2 ? 1.f : 0.f;
#pragma unroll
        for (int n = 0; n < 2; ++n) {
            const f32x4 w0 = wq[n][0], w1 = wq[n][1], w2 = wq[n][2]; const f32x4 w1m = w1 * m0, w0m = w0 * m01;
#pragma unroll
            for (int ai = 0; ai < 2; ++ai) {
                const int chunk = 2 * ai + wr;
                f32x4 gp;
                if (chunk > 0) { const PG8_LAS float* h = halo + ((chunk - 1) * 2) * 128 + cc + 4 * n;
                    const float s62 = rs.rr[(chunk - 1) * 64 + 62], s63 = rs.rr[(chunk - 1) * 64 + 63];
                    const f32x4 r62 = *(const PG8_LAS f32x4*)h * s62, r63 = *(const PG8_LAS f32x4*)(h + 128) * s63; gp = fr == 15 ? r63 : r62; }
                else { gp = (f32x4){0.f, 0.f, 0.f, 0.f}; }
#pragma unroll
                for (int m = 0; m < 4; ++m) {
                    float a[4]; const float rv = rl[ai * HALF + m * 16];
                    const f32x4 g = acc[ai][0][m][n] * rv; f32x4 y = w2 * g;
                    asm("s_nop 1\n\t"
                        "v_fmac_f32_dpp %0, %4, %12 row_shr:1 row_mask:0xf bank_mask:0xf\n\tv_fmac_f32_dpp %1, %5, %13 row_shr:1 row_mask:0xf bank_mask:0xf\n\t"
                        "v_fmac_f32_dpp %2, %6, %14 row_shr:1 row_mask:0xf bank_mask:0xf\n\tv_fmac_f32_dpp %3, %7, %15 row_shr:1 row_mask:0xf bank_mask:0xf\n\t"
                        "v_fmac_f32_dpp %0, %4, %16 row_shr:2 row_mask:0xf bank_mask:0xf\n\tv_fmac_f32_dpp %1, %5, %17 row_shr:2 row_mask:0xf bank_mask:0xf\n\t"
                        "v_fmac_f32_dpp %2, %6, %18 row_shr:2 row_mask:0xf bank_mask:0xf\n\tv_fmac_f32_dpp %3, %7, %19 row_shr:2 row_mask:0xf bank_mask:0xf\n\t"
                        "v_fmac_f32_dpp %0, %8, %20 row_ror:1 row_mask:0xf bank_mask:0xf\n\tv_fmac_f32_dpp %1, %9, %21 row_ror:1 row_mask:0xf bank_mask:0xf\n\t"
                        "v_fmac_f32_dpp %2, %10, %22 row_ror:1 row_mask:0xf bank_mask:0xf\n\tv_fmac_f32_dpp %3, %11, %23 row_ror:1 row_mask:0xf bank_mask:0xf\n\t"
                        "v_fmac_f32_dpp %0, %8, %24 row_ror:2 row_mask:0xf bank_mask:0xf\n\tv_fmac_f32_dpp %1, %9, %25 row_ror:2 row_mask:0xf bank_mask:0xf\n\t"
                        "v_fmac_f32_dpp %2, %10, %26 row_ror:2 row_mask:0xf bank_mask:0xf\n\tv_fmac_f32_dpp %3, %11, %27 row_ror:2 row_mask:0xf bank_mask:0xf"
                        : "+v"(y[0]), "+v"(y[1]), "+v"(y[2]), "+v"(y[3])
                        : "v"(g[0]), "v"(g[1]), "v"(g[2]), "v"(g[3]), "v"(gp[0]), "v"(gp[1]), "v"(gp[2]), "v"(gp[3]),
                          "v"(w1[0]), "v"(w1[1]), "v"(w1[2]), "v"(w1[3]), "v"(w0[0]), "v"(w0[1]), "v"(w0[2]), "v"(w0[3]),
                          "v"(w1m[0]), "v"(w1m[1]), "v"(w1m[2]), "v"(w1m[3]), "v"(w0m[0]), "v"(w0m[1]), "v"(w0m[2]), "v"(w0m[3]));
#pragma unroll
                    for (int e = 0; e < 4; ++e) a[e] = y[e] * __builtin_amdgcn_rcpf(1.0f + __expf(-y[e])) * (acc[ai][1][m][n][e] * rv);
                    gp = g;
                    u32x2 pk; pk.x = cvt_pk_bf16(a[0], a[1]); pk.y = cvt_pk_bf16(a[2], a[3]);
                    if (!(chunk == 0 && m == 0 && fr < 2)) *(u32x2*)(ACT + (size_t)(u.pm * BM + ai * HALF + wr * 64 + m * 16 + fr) * NF + col + 4 * n) = pk;
                }
            }
        }
    }
};
}
namespace fox {
typedef short bf16x8 __attribute__((ext_vector_type(8)));
typedef short s16x4 __attribute__((ext_vector_type(4)));
typedef float f32x16 __attribute__((ext_vector_type(16)));
typedef float f32x4 __attribute__((ext_vector_type(4)));
typedef unsigned u32x4 __attribute__((ext_vector_type(4)));
typedef unsigned short bf16;
constexpr int D = 128, SEQ = 8192, NHEAD = 16, OSTR = 4096;
constexpr float THR = 8.f;
constexpr float SCALE = 0.08838834764831845f;
constexpr int NW = 8, QBLK = 32, KVBLK = 64, QB = NW * QBLK;
constexpr int SHM_V = KVBLK * D * 2, SHM_K = KVBLK * D * 2;
constexpr int LDS_ATT = 2 * SHM_V + 2 * SHM_K + NW * 64 * 4;
constexpr int LDS_T = 69632;
constexpr int LDS_TOTAL = LDS_T + SEQ * 4;

#define KSWZ(row, colB) ((row) * 256 + ((colB) ^ (((row) & 7) << 4)))
#define SBAR() __builtin_amdgcn_sched_barrier(0)
__device__ __forceinline__ int v_st(int k, int c) { const int kk = (k & ~0xC) | ((k & 4) << 1) | ((k & 8) >> 1); return ((kk >> 3) * 4 + (c >> 5)) * 512 + ((kk & 7) * 32 + (c & 31)) * 2; }
__device__ __forceinline__ int v_rd_base(int lane) { return ((lane & 3) << 3) | (((lane >> 2) & 3) << 6) | (((lane >> 4) & 1) << 5) | (((lane >> 5) & 1) << 8); }
constexpr int v_rd_off(int d0, int ks, int half) { return d0 * 512 + ks * 4096 + half * 2048; }
__device__ __forceinline__ int crow(int r, int hi) { return (r & 3) + 8 * (r >> 2) + 4 * hi; }
typedef float cvtpk_f2 __attribute__((ext_vector_type(2))); typedef __bf16 cvtpk_b2 __attribute__((ext_vector_type(2)));
__device__ __forceinline__ unsigned cvtpk(float lo, float hi) { const cvtpk_f2 v = {lo, hi}; return __builtin_bit_cast(unsigned, __builtin_convertvector(v, cvtpk_b2)); }
__device__ __forceinline__ bf16x8 load8(const bf16* p) { return *reinterpret_cast<const bf16x8*>(p); }
__device__ __forceinline__ void mask_tile(f32x16& p0, f32x16& p1, int dq, unsigned W) {
    const float NEG = -__builtin_inff();
#pragma unroll
    for (int r = 0; r < 16; ++r) {
        const int c = (r & 3) + 8 * (r >> 2);
        if ((unsigned)(dq - c) >= W) p0[r] = NEG;
        if ((unsigned)(dq - c - 32) >= W) p1[r] = NEG;
    }
}
__device__ __forceinline__ void partialSM(f32x16& p0, f32x16& p1, float& m_reg, float& mn, float& alpha) {
    float pmax = p0[0]; for (int r = 1; r < 16; ++r) pmax = fmaxf(pmax, p0[r]); for (int r = 0; r < 16; ++r) pmax = fmaxf(pmax, p1[r]);
    { auto rr = __builtin_amdgcn_permlane32_swap(__float_as_uint(pmax), __float_as_uint(pmax), false, false);
      pmax = fmaxf(__uint_as_float(rr[0]), __uint_as_float(rr[1])); }
    constexpr float C2 = 1.4426950408889634f * SCALE;
    if (__builtin_expect(__all((pmax - m_reg) * SCALE <= THR), 1)) { mn = m_reg; alpha = 1.f; }
    else { mn = fmaxf(m_reg, pmax); alpha = __builtin_amdgcn_exp2f((m_reg - mn) * C2); m_reg = mn; }
    const float mnL = -mn * C2;
    for (int r = 0; r < 16; ++r) p0[r] = fmaf(p0[r], C2, mnL); for (int r = 0; r < 16; ++r) p1[r] = fmaf(p1[r], C2, mnL);
    for (int r = 0; r < 16; ++r) p0[r] = __builtin_amdgcn_exp2f(p0[r]);
}
__device__ __forceinline__ void finishSM(f32x16& p0, f32x16& p1, float alpha, float& l_reg, bf16x8& pa0, bf16x8& pa1, bf16x8& pa2, bf16x8& pa3) {
    for (int r = 0; r < 16; ++r) p1[r] = __builtin_amdgcn_exp2f(p1[r]);
    float ps = 0; for (int r = 0; r < 16; ++r) ps += p0[r]; for (int r = 0; r < 16; ++r) ps += p1[r];
    { auto rr = __builtin_amdgcn_permlane32_swap(__float_as_uint(ps), __float_as_uint(ps), false, false);
      ps = __uint_as_float(rr[0]) + __uint_as_float(rr[1]); }
    l_reg = l_reg * alpha + ps;
#define PK4(P, B_, OUT) do { unsigned a0 = cvtpk(P[B_+0], P[B_+1]), a1 = cvtpk(P[B_+2], P[B_+3]);                          \
        unsigned b0 = cvtpk(P[B_+4], P[B_+5]), b1 = cvtpk(P[B_+6], P[B_+7]);                                             \
        auto r0 = __builtin_amdgcn_permlane32_swap(a0, b0, false, false); auto r1 = __builtin_amdgcn_permlane32_swap(a1, b1, false, false); \
        u32x4 w = {r0[0], r1[0], r0[1], r1[1]}; OUT = *reinterpret_cast<bf16x8*>(&w); } while (0)
    PK4(p0, 0, pa0); PK4(p0, 8, pa1); PK4(p1, 0, pa2); PK4(p1, 8, pa3);
#undef PK4
}
template <int KB>
__device__ __forceinline__ void qkt(f32x16& p0, f32x16& p1, const char* K_lds, int r32, int hi, const bf16x8* qr, const float* tb) {
    { const f32x4 a0 = *(const f32x4*)(tb), a1 = *(const f32x4*)(tb + 8), a2 = *(const f32x4*)(tb + 16), a3 = *(const f32x4*)(tb + 24);
      const f32x4 b0 = *(const f32x4*)(tb + 32), b1 = *(const f32x4*)(tb + 40), b2 = *(const f32x4*)(tb + 48), b3 = *(const f32x4*)(tb + 56);
      p0 = (f32x16){a0[0], a0[1], a0[2], a0[3], a1[0], a1[1], a1[2], a1[3], a2[0], a2[1], a2[2], a2[3], a3[0], a3[1], a3[2], a3[3]};
      p1 = (f32x16){b0[0], b0[1], b0[2], b0[3], b1[0], b1[1], b1[2], b1[3], b2[0], b2[1], b2[2], b2[3], b3[0], b3[1], b3[2], b3[3]}; }
    const char* kb[4];
#pragma unroll
    for (int dd = 0; dd < 4; ++dd) kb[dd] = K_lds + KB * SHM_K + KSWZ(r32, (dd * 16 + hi * 8) * 2);
#pragma unroll
    for (int d0 = 0; d0 < 8; ++d0) { const char* a = kb[d0 & 3] + (d0 >> 2) * 128;
        bf16x8 b0 = *reinterpret_cast<const bf16x8*>(a);
        bf16x8 b1 = *reinterpret_cast<const bf16x8*>(a + 32 * 256);
        p0 = __builtin_amdgcn_mfma_f32_32x32x16_bf16(b0, qr[d0], p0, 0, 0, 0);
        p1 = __builtin_amdgcn_mfma_f32_32x32x16_bf16(b1, qr[d0], p1, 0, 0, 0); }
}
template <int VB>
__device__ __forceinline__ void pv_tile(f32x16* o, int vb0, bf16x8 pa0, bf16x8 pa1, bf16x8 pa2, bf16x8 pa3) {
#define TRRD(dst, off) asm volatile("ds_read_b64_tr_b16 %0, %1 offset:%2" : "=&v"(dst) : "v"(vb0), "i"(off) : "memory")
#define PV_D0(d0) do { s16x4 l0, l1, l2, l3, h0, h1, h2, h3; constexpr int b_ = VB * SHM_V + v_rd_off(d0, 0, 0); \
        TRRD(l0, b_); TRRD(h0, b_ + 2048); TRRD(l1, b_ + 4096); TRRD(h1, b_ + 6144); TRRD(l2, b_ + 8192); TRRD(h2, b_ + 10240); TRRD(l3, b_ + 12288); TRRD(h3, b_ + 14336); \
        asm volatile("s_waitcnt lgkmcnt(0)" ::: "memory"); SBAR();   \
        o[d0] = __builtin_amdgcn_mfma_f32_32x32x16_bf16(pa0, (bf16x8){l0[0], l0[1], l0[2], l0[3], h0[0], h0[1], h0[2], h0[3]}, o[d0], 0, 0, 0);   \
        o[d0] = __builtin_amdgcn_mfma_f32_32x32x16_bf16(pa1, (bf16x8){l1[0], l1[1], l1[2], l1[3], h1[0], h1[1], h1[2], h1[3]}, o[d0], 0, 0, 0);   \
        o[d0] = __builtin_amdgcn_mfma_f32_32x32x16_bf16(pa2, (bf16x8){l2[0], l2[1], l2[2], l2[3], h2[0], h2[1], h2[2], h2[3]}, o[d0], 0, 0, 0);   \
        o[d0] = __builtin_amdgcn_mfma_f32_32x32x16_bf16(pa3, (bf16x8){l3[0], l3[1], l3[2], l3[3], h3[0], h3[1], h3[2], h3[3]}, o[d0], 0, 0, 0); } while (0)
    PV_D0(0); PV_D0(1); PV_D0(2); PV_D0(3);
#undef PV_D0
#undef TRRD
}
struct BlockRef { const bf16* Q; const bf16* K; const bf16* V; bf16* O; int P0; int jlo; };
struct Seam { bf16x8 qr[8]; bf16x8 st_v0, st_v1, st_k0, st_k1; };
#define ROWU(p, k0, rr) ((const char*)(p) + (size_t)((k0) + (rr)) * (D * 2))
#define LD8U(pu) (*(const bf16x8*)((pu) + lofs))
#define VMW() asm volatile("s_waitcnt vmcnt(0)" ::: "memory")
#define VMWN(n) asm volatile("s_waitcnt vmcnt(%0)" :: "i"(n) : "memory")
#define SLOAD_H(Kp, Vp, k0) do { S.st_v0 = LD8U(ROWU(Vp, k0, 0)); S.st_v1 = LD8U(ROWU(Vp, k0, 32));              \
                         S.st_k0 = LD8U(ROWU(Kp, k0, 0)); S.st_k1 = LD8U(ROWU(Kp, k0, 32)); } while (0)
#define SWRITE_HK(bf) do { *(bf16x8*)(K_lds + (bf) * SHM_K + kws) = S.st_k0; *(bf16x8*)(K_lds + (bf) * SHM_K + kws + 32 * 256) = S.st_k1; } while (0)
#define SWRITE_HV(bf) do { *(bf16x8*)(V_lds + (bf) * SHM_V + vst0) = S.st_v0; *(bf16x8*)(V_lds + (bf) * SHM_V + vst1) = S.st_v1; } while (0)
#define SWRITE_H(bf) do { SWRITE_HV(bf); SWRITE_HK(bf); } while (0)
__device__ __forceinline__ void fox_prime(const BlockRef& cur, char* lds, Seam& S, const int tid) {
    const int wid = __builtin_amdgcn_readfirstlane(tid >> 6), lane = tid & 63, r32 = lane & 31, hi = lane >> 5;
    const int sr = tid >> 4, sc = (tid & 15) * 8, kws = KSWZ(sr, sc * 2); char* K_lds = lds + 2 * SHM_V; const unsigned lofs = (unsigned)(sr * D + sc) * 2u;
    { const unsigned qofs = (unsigned)(r32 * D + hi * 8) * 2u; const char* qb_ = (const char*)cur.Q + (size_t)(wid * QBLK) * (D * 2);
      for (int d0 = 0; d0 < 8; ++d0) S.qr[d0] = *(const bf16x8*)(qb_ + qofs + d0 * 32); }
    SLOAD_H(cur.K, cur.V, cur.jlo * KVBLK); VMW(); SWRITE_HK(0);
    __syncthreads();
}
__device__ __forceinline__ void fox_block(const BlockRef& cur, const BlockRef& nxt, char* lds, Seam& S, const int tid) {
    const int wid = __builtin_amdgcn_readfirstlane(tid >> 6), lane = tid & 63, r32 = lane & 31, hi = lane >> 5;
    const int j_lo = cur.jlo; const int NT = (cur.P0 + QB) / KVBLK - j_lo;
    const int qlo = cur.P0 + wid * QBLK, qm = qlo + r32 - 4 * hi;
    char* V_lds = lds; char* K_lds = lds + 2 * SHM_V;
    float* ws = (float*)(lds + 2 * SHM_V + 2 * SHM_K) + wid * 64; float* li_l = ws, * al_l = ws + 32;
    const float* tbl = (const float*)(lds + LDS_T) + 4 * hi;
    float m_reg = -1e30f, l_reg = 0; f32x16 o[4] = {};
    const int sr = tid >> 4, sc = (tid & 15) * 8, vst0 = v_st(sr, sc), vst1 = v_st(32 + sr, sc), kws = KSWZ(sr, sc * 2); const unsigned lofs = (unsigned)(sr * D + sc) * 2u;
    const int vb0 = (int)(uintptr_t)V_lds + v_rd_base(lane);
    const bf16* Kh = cur.K; const bf16* Vh = cur.V;
    constexpr int W = 1 << 30;
#define RESC(a) do { if (__any((a) < 1.f)) { if (hi == 0) al_l[r32] = (a); asm volatile("s_waitcnt lgkmcnt(0)" ::: "memory");              \
                     for (int d_ = 0; d_ < 4; ++d_) for (int r = 0; r < 16; ++r) o[d_][r] *= al_l[crow(r, hi)]; } } while (0)
#define KBASE(t) ((j_lo + (t)) * KVBLK)
#define MASKT(P0_, P1_, t) do { const int kb_ = KBASE(t); if (kb_ + KVBLK - 1 > qlo) mask_tile(P0_, P1_, qm - kb_, (unsigned)W); } while (0)
    constexpr int NQL = 8;
#define SEAM_K0() do { VMWN(NQL); SWRITE_HK(0); SBAR(); } while (0)
    f32x16 pA0, pA1, pB0, pB1; float mnA, mnB, alA, alB; bf16x8 pa0, pa1, pa2, pa3;
    SWRITE_HV(0); SBAR();
    if (NT > 1) { SLOAD_H(Kh, Vh, KBASE(1)); }
    SBAR(); qkt<0>(pA0, pA1, K_lds, r32, hi, S.qr, tbl + KBASE(0));
    MASKT(pA0, pA1, 0); partialSM(pA0, pA1, m_reg, mnA, alA);
    if (NT > 1) { VMW(); SWRITE_H(1); }
    __syncthreads();
#define HALF_STEP(PX0, PX1, mnX, alX, PY0, PY1, alY, t, KB, VB, SB) do {                                                      \
        SBAR(); qkt<KB>(PX0, PX1, K_lds, r32, hi, S.qr, tbl + KBASE(t));                                                      \
        finishSM(PY0, PY1, alY, l_reg, pa0, pa1, pa2, pa3); SBAR();                                                           \
        if ((t) + 1 < NT) { SLOAD_H(Kh, Vh, KBASE((t) + 1)); SBAR(); }                                                        \
        pv_tile<VB>(o, vb0, pa0, pa1, pa2, pa3); MASKT(PX0, PX1, (t)); partialSM(PX0, PX1, m_reg, mnX, alX);                  \
        __syncthreads();                                                                                                      \
        if ((t) + 1 < NT) { VMW(); SWRITE_H(SB); }                                                                            \
        RESC(alX); __syncthreads(); } while (0)
    for (int t = 1; t + 1 < NT; t += 2) {
        HALF_STEP(pB0, pB1, mnB, alB, pA0, pA1, alA, t, 1, 0, 0);
        HALF_STEP(pA0, pA1, mnA, alA, pB0, pB1, alB, t + 1, 0, 1, 1);
    }
    const bool even = (NT & 1) == 0;
    if (even) { SBAR(); qkt<1>(pB0, pB1, K_lds, r32, hi, S.qr, tbl + KBASE(NT - 1)); SBAR(); }
    SLOAD_H(nxt.K, nxt.V, nxt.jlo * KVBLK); SBAR();
    { const unsigned qofs = (unsigned)(r32 * D + hi * 8) * 2u; const char* qb_ = (const char*)nxt.Q + (size_t)(wid * QBLK) * (D * 2);
#pragma unroll
      for (int d0 = 0; d0 < 8; ++d0) S.qr[d0] = *(const bf16x8*)(qb_ + qofs + d0 * 32); }
    SBAR();
    finishSM(pA0, pA1, alA, l_reg, pa0, pa1, pa2, pa3); SBAR();
    pv_tile<0>(o, vb0, pa0, pa1, pa2, pa3);
    if (even) { MASKT(pB0, pB1, NT - 1); partialSM(pB0, pB1, m_reg, mnB, alB); __syncthreads(); RESC(alB);
        finishSM(pB0, pB1, alB, l_reg, pa0, pa1, pa2, pa3); SBAR(); pv_tile<1>(o, vb0, pa0, pa1, pa2, pa3); }
    SBAR(); SEAM_K0();
    if (hi == 0) li_l[r32] = l_reg; asm volatile("s_waitcnt lgkmcnt(0)" ::: "memory");
    float rli[16];
#pragma unroll
    for (int r = 0; r < 16; ++r) rli[r] = __builtin_amdgcn_rcpf(li_l[crow(r, hi)]);
    bf16* Ow = cur.O + (size_t)(wid * QBLK) * OSTR;
#pragma unroll
    for (int r = 0; r < 16; ++r) { const int orow = crow(r, hi);
#pragma unroll
        for (int d0 = 0; d0 < 4; ++d0) { const float v = o[d0][r] * rli[r];
            const float vn = __shfl_xor(v, 1);
            if ((r32 & 1) == 0) *(unsigned*)(Ow + (size_t)orow * OSTR + d0 * 32 + r32) = cvtpk(v, vn); } }
    __syncthreads();
#undef RESC
#undef KBASE
#undef MASKT
#undef SEAM_K0
#undef HALF_STEP
}
#undef ROWU
#undef LD8U
#undef VMW
#undef VMWN
#undef SLOAD_H
#undef SWRITE_HK
#undef SWRITE_HV
#undef SWRITE_H
#undef KSWZ
#undef SBAR
}
#define GAS __attribute__((address_space(1)))
#define LAS __attribute__((address_space(3)))
typedef unsigned short bf16;
typedef unsigned v4u __attribute__((ext_vector_type(4)));
typedef float f32x4 __attribute__((ext_vector_type(4)));
typedef short bf16x8 __attribute__((ext_vector_type(8)));
typedef GAS unsigned gu32;
typedef GAS unsigned long long gu64;
#define RLX_AGENT __ATOMIC_RELAXED, __HIP_MEMORY_SCOPE_AGENT
#define LDS_WAIT() asm volatile("s_waitcnt lgkmcnt(0)" ::: "memory")
#define VM_WAIT() asm volatile("s_waitcnt vmcnt(0)" ::: "memory")
__device__ __forceinline__ unsigned long long rt() { return __builtin_amdgcn_s_memrealtime(); }
__device__ __forceinline__ unsigned f2bf(float f) { unsigned u = __builtin_bit_cast(unsigned, f); return (u + 0x7fffu + ((u >> 16) & 1u)) >> 16; }
typedef float pk2_f32x2 __attribute__((ext_vector_type(2))); typedef __bf16 pk2_bf16x2 __attribute__((ext_vector_type(2)));
__device__ __forceinline__ unsigned pk2(float lo, float hi) { const pk2_f32x2 v = {lo, hi}; return __builtin_bit_cast(unsigned, __builtin_convertvector(v, pk2_bf16x2)); }

#define XB_TMO      128
#define XB_XCNT(j)  (256  + 64 * (j))
#define XB_XSUB(j)  (1280 + 64 * (j))
#define XB_XGEN(j)  (2304 + 64 * (j))
#define XB_TOP      3328
#define XB_TOPGEN   3392
#define XCD_BAR_WORDS 3456
#define XB_SPIN_CAP (1u << 18)

__device__ __forceinline__ unsigned xb_ld(unsigned* p)              { return __hip_atomic_load(p, __ATOMIC_RELAXED, __HIP_MEMORY_SCOPE_AGENT); }
__device__ __forceinline__ unsigned xb_add(unsigned* p, unsigned v) { return __hip_atomic_fetch_add(p, v, __ATOMIC_RELAXED, __HIP_MEMORY_SCOPE_AGENT); }
__device__ __forceinline__ unsigned xb_xcc_id() { return (unsigned)__builtin_amdgcn_s_getreg((3 << 11) | 20) & 0xFu; }
#define XB_SPIN(cond, bar) do { unsigned _sp = 0; while (cond) { __builtin_amdgcn_s_sleep(1); \
    if ((++_sp & 255u) == 0u) { if (xb_ld(&(bar)[XB_TMO])) break; if (_sp > XB_SPIN_CAP) { atomicAdd(&(bar)[XB_TMO], 1u); break; } } } } while (0)

struct XcdBarrier {
    unsigned* bar; unsigned x;
    volatile LAS unsigned* st;
};

__device__ __forceinline__ XcdBarrier xcd_barrier_post(unsigned* bar, volatile LAS unsigned* st) {
    XcdBarrier b; b.bar = bar; b.x = xb_xcc_id(); b.st = st;
    if (threadIdx.x == 0) (void)xb_add(&bar[XB_XCNT(b.x)], 1u);
    return b;
}
__device__ __forceinline__ void xcd_barrier_complete(unsigned* bar, unsigned x, unsigned& nloc, unsigned& nx) {
    const unsigned G = gridDim.x * gridDim.y * gridDim.z;
    unsigned sum, cnt, mine, sp = 0u;
    for (;;) {
        sum = 0u; cnt = 0u; mine = 0u;
#pragma unroll
        for (unsigned j = 0; j < 16; ++j) { const unsigned c = xb_ld(&bar[XB_XCNT(j)]); sum += c; cnt += (c > 0u) ? 1u : 0u; mine = (j == x) ? c : mine; }
        if (sum == G) break;
        __builtin_amdgcn_s_sleep(1);
        if ((++sp & 255u) == 0u) { if (xb_ld(&bar[XB_TMO])) break; if (sp > XB_SPIN_CAP) { atomicAdd(&bar[XB_TMO], 1u); break; } }
    }
    nloc = mine > 0u ? mine : 1u; nx = cnt > 0u ? cnt : 1u;
}

__device__ __forceinline__ void xcd_barrier(const XcdBarrier& b) {
    asm volatile("s_waitcnt vmcnt(0)" ::: "memory");
    __syncthreads();
    if (threadIdx.x == 0) {
        unsigned* bar = b.bar;
        __builtin_amdgcn_s_waitcnt(0);
        unsigned nloc = b.st[0], nx = b.st[1];
        if (nloc == 0u) { xcd_barrier_complete(bar, b.x, nloc, nx); b.st[0] = nloc; b.st[1] = nx; }
        const unsigned old = xb_add(&bar[XB_XSUB(b.x)], 1u);
        const unsigned gen = old / nloc;
        if (old + 1u == (gen + 1u) * nloc) {
            __builtin_amdgcn_fence(__ATOMIC_RELEASE, "agent");
            asm volatile("s_waitcnt vmcnt(0)" ::: "memory");
            const unsigned og = xb_add(&bar[XB_TOP], 1u);
            const unsigned tg = og / nx;
            if (og + 1u == (tg + 1u) * nx) xb_add(&bar[XB_TOPGEN], 1u);
            else XB_SPIN(xb_ld(&bar[XB_TOPGEN]) == tg, bar);
            __builtin_amdgcn_fence(__ATOMIC_ACQUIRE, "agent");
            xb_add(&bar[XB_XGEN(b.x)], 1u);
            asm volatile("s_waitcnt vmcnt(0)" ::: "memory");
        } else {
            XB_SPIN(xb_ld(&bar[XB_XGEN(b.x)]) == gen, bar);
            __builtin_amdgcn_fence(__ATOMIC_ACQUIRE, "agent");
            asm volatile("s_waitcnt vmcnt(0)" ::: "memory");
        }
    }
    __syncthreads();
}
constexpr int NWAVES = 8;
constexpr int SEQ = 8192, DM = 4096, HW = 2048, DFF = 11008, NH = 16;
constexpr float EPS = 1e-6f;
constexpr float ATT_SCALE = 0.08838834764831845f;
constexpr size_t MiB = 1u << 20;
constexpr size_t WS_CTL = 0, CTL_ZERO_BYTES = 64 * 1024;
constexpr size_t WS_WF = 1 * MiB;
constexpr size_t WS_WSGU = 2 * MiB;
constexpr size_t WS_LF = 3 * MiB;
constexpr size_t WS_T = 4 * MiB;
constexpr size_t WS_SSP = 5 * MiB;
constexpr size_t WS_WPOOL = 6 * MiB;
constexpr size_t WS_W0IN = 8 * MiB;
constexpr size_t WS_W0OUT = 72 * MiB;
constexpr size_t WS_W0UP = 104 * MiB;
constexpr size_t WS_W0DN = 276 * MiB;
constexpr size_t WS_W1IN = 362 * MiB;
constexpr size_t WS_W1OUT = 442 * MiB;
constexpr size_t WS_W1UP = 474 * MiB;
constexpr size_t WS_W1DN = 646 * MiB;
constexpr size_t WS_XN = 732 * MiB;
constexpr size_t WS_ACT = 796 * MiB;
constexpr size_t WS_R = 968 * MiB;
constexpr size_t WS_QKV = WS_R;
constexpr size_t WS_ZP = WS_R + 96 * MiB;
constexpr size_t WS_PL = WS_R + 128 * MiB;
constexpr size_t WS_P1 = WS_R;
constexpr size_t WS_VST = WS_R + 128 * MiB;
constexpr size_t WS_CC = WS_R + 160 * MiB;
constexpr size_t WS_GU = WS_R;
constexpr size_t WS_HG = WS_R + 256 * MiB;
constexpr size_t WS_HU = WS_R + 264 * MiB;
constexpr size_t WS_END = WS_R + 344 * MiB;
constexpr int CW_BAR = 4096;
constexpr int RING_BYTES = 131072, LDSCTL_OFF = RING_BYTES, MISC_OFF = LDSCTL_OFF + 320, HALO_OFF = RING_BYTES + 1024, RR_OFF = HALO_OFF + 4096, RED_OFF = RR_OFF + 1024, LDS_BYTES = 147456;

struct Frame {
    LAS unsigned char* lds; volatile LAS unsigned* MISC; int wave, vcu, G;
};
__device__ __forceinline__ float wave_sum(float v) {
#pragma unroll
    for (int o = 1; o < 64; o <<= 1) v += __shfl_xor(v, o);
    return v;
}
__device__ __forceinline__ float bf2f(unsigned short b) { return __builtin_bit_cast(float, (unsigned)b << 16); }
__device__ __forceinline__ float bflo(unsigned w) { return __builtin_bit_cast(float, w << 16); }
__device__ __forceinline__ float bfhi(unsigned w) { return __builtin_bit_cast(float, w & 0xffff0000u); }
struct TrJob { const float* src; const float* gk; bf16* dst; int ld, K, k0; };
__device__ __forceinline__ void tr_load(float (&t)[32], const TrJob& j, int lane) {
    const float* sp = j.src + (size_t)(j.k0 + 32 * (lane >> 5)) * j.ld + (lane & 31);
#pragma unroll
    for (int i = 0; i < 32; ++i) t[i] = __builtin_nontemporal_load(sp + (size_t)i * j.ld);
}
__device__ __forceinline__ void tr_store(const float (&t)[32], const TrJob& j, LAS float* scr, int lane) {
    LAS unsigned char* sb = (LAS unsigned char*)scr;
    v4u w[4];
    if (j.gk) { const GAS f32x4* gp = (const GAS f32x4*)(j.gk + j.k0 + 32 * (lane >> 5));
#pragma unroll
        for (int q = 0; q < 4; ++q) { const f32x4 ga = gp[2 * q], gb = gp[2 * q + 1];
            w[q].x = pk2(t[8 * q] * ga.x, t[8 * q + 1] * ga.y); w[q].y = pk2(t[8 * q + 2] * ga.z, t[8 * q + 3] * ga.w); w[q].z = pk2(t[8 * q + 4] * gb.x, t[8 * q + 5] * gb.y); w[q].w = pk2(t[8 * q + 6] * gb.z, t[8 * q + 7] * gb.w); }
    } else {
#pragma unroll
        for (int q = 0; q < 4; ++q) { w[q].x = pk2(t[8 * q], t[8 * q + 1]); w[q].y = pk2(t[8 * q + 2], t[8 * q + 3]); w[q].z = pk2(t[8 * q + 4], t[8 * q + 5]); w[q].w = pk2(t[8 * q + 6], t[8 * q + 7]); }
    }
    { LAS v4u* wp = (LAS v4u*)(sb + (lane & 31) * 144 + (lane >> 5) * 64);
#pragma unroll
      for (int q = 0; q < 4; ++q) wp[q] = w[q]; }
    LDS_WAIT(); asm volatile("" ::: "memory");
    const int c = lane & 7;
#pragma unroll
    for (int jj = 0; jj < 4; ++jj) { const int n = (lane >> 3) + 8 * jj;
        *(GAS v4u*)(j.dst + (size_t)n * j.K + j.k0 + 8 * c) = *(const LAS v4u*)(sb + n * 144 + 16 * c); }
    LDS_WAIT(); asm volatile("" ::: "memory");
}
__device__ __forceinline__ int map_ident(int n) { return n; }
__device__ __forceinline__ int map_w0in(int n) { return n < 6144 ? n : n + 16; }
__device__ __forceinline__ int map_up(int n) { const int j = n >> 8, i = n & 255; return i < 128 ? 128 * j + i : DFF + 128 * j + (i - 128); }
__device__ __forceinline__ void xb_rows(const float* X, bf16* XB, float* ss, int m0, int mstep, int lane) {
    if (m0 >= SEQ) return;
    f32x4 v[16], vn[16];
    { const GAS f32x4* xr = (const GAS f32x4*)(X + (size_t)m0 * DM) + lane;
#pragma unroll
      for (int j = 0; j < 16; ++j) v[j] = __builtin_nontemporal_load(xr + 64 * j); }
    for (int m = m0; m < SEQ; m += mstep) {
        const bool more = m + mstep < SEQ;
        if (more) { const GAS f32x4* xr = (const GAS f32x4*)(X + (size_t)(m + mstep) * DM) + lane;
#pragma unroll
            for (int j = 0; j < 16; ++j) vn[j] = __builtin_nontemporal_load(xr + 64 * j); }
        float s = 0.f;
#pragma unroll
        for (int j = 0; j < 16; ++j) s += (v[j].x * v[j].x + v[j].y * v[j].y) + (v[j].z * v[j].z + v[j].w * v[j].w);
        s = wave_sum(s); if (lane == 0) ss[m] = s;
        GAS unsigned long long* o8 = (GAS unsigned long long*)(XB + (size_t)m * DM) + lane;
#pragma unroll
        for (int j = 0; j < 16; ++j) o8[64 * j] = (unsigned long long)pk2(v[j].x, v[j].y) | ((unsigned long long)pk2(v[j].z, v[j].w) << 32);
        if (more) {
#pragma unroll
            for (int j = 0; j < 16; ++j) v[j] = vn[j]; }
    }
}

struct Args { const float* in[24]; float* out; unsigned char* ws; int ph_lo, ph_hi; };
enum { I_X = 0, I_L0_MIXN, I_L0_WIN, I_L0_BF, I_L0_QG, I_L0_KG, I_L0_POOLW, I_L0_POOLS, I_L0_WOUT, I_L0_FFNN, I_L0_WUP, I_L0_FCONV, I_L0_WDN,
       I_L1_MIXN, I_L1_WIN, I_L1_CONVW, I_L1_SGUN, I_L1_SGUW, I_L1_SGUB, I_L1_WOUT, I_L1_FFNN, I_L1_WUP, I_L1_FCONV, I_L1_WDN };

constexpr int IT_W0IN = (4096 / 64) * (8192 / 32), IT_WOUT = (4096 / 64) * (4096 / 32), IT_UP = (4096 / 64) * (22016 / 32), IT_DN = (11008 / 64) * (4096 / 32),
              IT_W1IN = (4096 / 64) * (10240 / 32), IT_POOL = (512 / 64) * (512 / 32);
constexpr int P0_NITEMS = IT_W0IN;
constexpr int CV_TAIL = IT_UP / 2;
constexpr int CV_NITEMS = IT_W1IN + 2 * (IT_WOUT + IT_UP) + IT_DN + 4 * IT_POOL - CV_TAIL;
template <bool FIRST> __device__ __forceinline__ TrJob tr_job(const Args& a, int r) {
    unsigned char* ws = a.ws; TrJob j;
#define TRJOB(NIT, SRCI, LD, KD, ND, DSTOFF, MAP, GAIN) if (r < (NIT)) { constexpr int nb_ = (ND) / 32; const int kb_ = r / nb_, n0_ = 32 * (r % nb_); \
        j.src = a.in[SRCI] + MAP(n0_); j.gk = GAIN; j.dst = (bf16*)(ws + (DSTOFF)) + (size_t)n0_ * (KD); j.ld = LD; j.K = KD; j.k0 = 64 * kb_; return j; } r -= (NIT);
    if (FIRST) { TRJOB(IT_W0IN, I_L0_WIN, 8208, 4096, 8192, WS_W0IN, map_w0in, a.in[I_L0_MIXN]) }
    TRJOB(IT_WOUT, I_L0_WOUT, 4096, 4096, 4096, WS_W0OUT, map_ident, nullptr)
    TRJOB(IT_UP, I_L0_WUP, 22016, 4096, 22016, WS_W0UP, map_up, a.in[I_L0_FFNN])
    TRJOB(IT_DN, I_L0_WDN, 4096, 11008, 4096, WS_W0DN, map_ident, nullptr)
    TRJOB(IT_W1IN, I_L1_WIN, 10240, 4096, 10240, WS_W1IN, map_ident, a.in[I_L1_MIXN])
    TRJOB(IT_WOUT, I_L1_WOUT, 4096, 4096, 4096, WS_W1OUT, map_ident, nullptr)
    if (r < 4 * IT_POOL) { const int g_ = r / IT_POOL; r -= g_ * IT_POOL; constexpr int nb_ = 512 / 32; const int kb_ = r / nb_, n0_ = 32 * (r % nb_);
      j.src = a.in[I_L0_POOLW] + (size_t)g_ * 512 * 512 + n0_; j.gk = nullptr; j.dst = (bf16*)(ws + WS_WPOOL) + (size_t)g_ * 512 * 512 + (size_t)n0_ * 512; j.ld = 512; j.K = 512; j.k0 = 64 * kb_; return j; }
    r -= 4 * IT_POOL;
    TRJOB(IT_UP, I_L1_WUP, 22016, 4096, 22016, WS_W1UP, map_up, a.in[I_L1_FFNN])
#undef TRJOB
    return j;
}
__device__ __forceinline__ void p0_prologue(Frame& F, const Args& a) {
    unsigned char* ws = a.ws;
    LAS float* scr = (LAS float*)(F.lds + F.wave * 16384);
    const int gw = F.vcu * NWAVES + F.wave, NGW = F.G * NWAVES;
    constexpr int NITEMS = P0_NITEMS;
    if (gw < NITEMS) {
        float t[32], t2[32]; TrJob j0 = tr_job<true>(a, gw), j1 = j0; const int lane = (int)threadIdx.x & 63;
        tr_load(t, j0, lane);
        for (int it = gw; it < NITEMS; it += NGW) {
            const bool more = it + NGW < NITEMS;
            if (more) { j1 = tr_job<true>(a, it + NGW); tr_load(t2, j1, lane); }
            tr_store(t, j0, scr, lane);
            if (more) { j0 = j1;
#pragma unroll
                for (int i = 0; i < 32; ++i) t[i] = t2[i]; }
        }
    }
    const int gt = F.vcu * (NWAVES * 64) + ((int)threadIdx.x), NGT = F.G * NWAVES * 64;
    { bf16* wf = (bf16*)(ws + WS_WF); const float* src = a.in[I_L0_WIN];
      for (int e = gt; e < 16 * 4096; e += NGT) { const int n = e >> 12, k = e & 4095; wf[e] = (bf16)f2bf(src[(size_t)k * 8208 + 6144 + n] * a.in[I_L0_MIXN][k]); } }
    { bf16* wsg = (bf16*)(ws + WS_WSGU); const float* src = a.in[I_L1_SGUW];
      for (int e = gt; e < 16 * 128 * 128; e += NGT) { const int t = (e >> 7) & 127, s = e & 127; wsg[e] = (s <= t) ? (bf16)f2bf(src[e]) : (bf16)0; } }
    xb_rows(a.in[I_X], (bf16*)(ws + WS_XN), (float*)(ws + WS_SSP), gw, NGW, ((int)threadIdx.x & 63));
}

constexpr int CW_CVQ = 8256;
__device__ __forceinline__ void cv_queue(Frame& F, const Args& a) {
    LAS float* scr = (LAS float*)(F.lds + F.wave * 16384); const int lane = (int)threadIdx.x & 63; gu32* ctl = (gu32*)(a.ws + WS_CTL);
    for (;;) {
        unsigned base = 0; if (lane == 0) base = __hip_atomic_fetch_add(ctl + CW_CVQ, 8u, RLX_AGENT);
        base = (unsigned)__builtin_amdgcn_readfirstlane((int)base);
        if (base >= (unsigned)CV_NITEMS) break;
        const int n = (int)base + 8 <= CV_NITEMS ? 8 : CV_NITEMS - (int)base;
        float t[32], t2[32], t3[32]; TrJob j0 = tr_job<false>(a, (int)base), j1 = j0, j2 = j0;
        tr_load(t, j0, lane);
        if (n > 1) { j1 = tr_job<false>(a, (int)base + 1); tr_load(t2, j1, lane); }
        for (int i = 0; i < n; ++i) {
            if (i + 2 < n) { j2 = tr_job<false>(a, (int)base + i + 2); tr_load(t3, j2, lane); }
            tr_store(t, j0, scr, lane);
            j0 = j1; j1 = j2;
#pragma unroll
            for (int k = 0; k < 32; ++k) { t[k] = t2[k]; t2[k] = t3[k]; } }
    }
}
__device__ __forceinline__ void cv_static(Frame& F, const Args& a, int lo, int n, int wk, int nwk) {
    LAS float* scr = (LAS float*)(F.lds + F.wave * 16384); const int lane = (int)threadIdx.x & 63;
    const int r0 = wk * NWAVES + F.wave, st = nwk * NWAVES;
    if (r0 < n) {
        float t[32], t2[32]; TrJob j0 = tr_job<false>(a, lo + r0), j1 = j0;
        tr_load(t, j0, lane);
        for (int r = r0; r < n; r += st) { const bool more = r + st < n;
            if (more) { j1 = tr_job<false>(a, lo + r + st); tr_load(t2, j1, lane); }
            tr_store(t, j0, scr, lane);
            if (more) { j0 = j1;
#pragma unroll
                for (int i = 0; i < 32; ++i) t[i] = t2[i]; } }
    }
}
__device__ __forceinline__ void convert_w1dn(Frame& F, const Args& a, int wk, int nwk) {
    LAS float* scr = (LAS float*)(F.lds + F.wave * 16384); const int lane = (int)threadIdx.x & 63;
    constexpr int nb = 4096 / 32, nitems = (11008 / 64) * nb; const int r0 = wk * NWAVES + F.wave, st = nwk * NWAVES;
    if (r0 < nitems) {
        float t[32], t2[32]; TrJob j0, j1; j0.gk = nullptr; j0.ld = 4096; j0.K = 11008; j1 = j0;
        j0.src = a.in[I_L1_WDN] + 32 * (r0 % nb); j0.dst = (bf16*)(a.ws + WS_W1DN) + (size_t)(32 * (r0 % nb)) * 11008; j0.k0 = 64 * (r0 / nb);
        tr_load(t, j0, lane);
        for (int r = r0; r < nitems; r += st) { const int rn = r + st; const bool more = rn < nitems;
            if (more) { j1.src = a.in[I_L1_WDN] + 32 * (rn % nb); j1.dst = (bf16*)(a.ws + WS_W1DN) + (size_t)(32 * (rn % nb)) * 11008; j1.k0 = 64 * (rn / nb); tr_load(t2, j1, lane); }
            tr_store(t, j0, scr, lane);
            if (more) { j0 = j1;
#pragma unroll
                for (int i = 0; i < 32; ++i) t[i] = t2[i]; } }
    }
}
__device__ __forceinline__ void p_logits(const Args& a, int gw, int NGW) {
    unsigned char* ws = a.ws; const int lane = (int)threadIdx.x & 63;
    {
        const bf16* XN = (const bf16*)(ws + WS_XN); const bf16* WF = (const bf16*)(ws + WS_WF); float* LF = (float*)(ws + WS_LF);
        for (int grp = gw; grp < SEQ / 16; grp += NGW) {
            const bf16* ap = XN + (size_t)(grp * 16 + (lane & 15)) * DM + (lane >> 4) * 8; const bf16* bp = WF + (size_t)(lane & 15) * DM + (lane >> 4) * 8;
            f32x4 acc = (f32x4){0.f, 0.f, 0.f, 0.f};
#pragma unroll 8
            for (int k0 = 0; k0 < DM; k0 += 32) acc = __builtin_amdgcn_mfma_f32_16x16x32_bf16(*(const bf16x8*)(ap + k0), *(const bf16x8*)(bp + k0), acc, 0, 0, 0);
            const int head = lane & 15; const float bias = a.in[I_L0_BF][head]; const float* ss = (const float*)(ws + WS_SSP);
#pragma unroll
            for (int j = 0; j < 4; ++j) { const float x = acc[j] * (1.0f / sqrtf(ss[grp * 16 + 4 * (lane >> 4) + j] * (1.f / DM) + EPS)) + bias; LF[(size_t)head * SEQ + grp * 16 + 4 * (lane >> 4) + j] = fminf(x, 0.f) - log1pf(__expf(-fabsf(x))); }
        }
    }
}
template <int W> __device__ __forceinline__ void pool_task(unsigned char* ws, int task) {
    const bf16* ZP = (const bf16*)(ws + WS_ZP); bf16* PL = (bf16*)(ws + WS_PL);
    const int strip = task >> 8, q = task & 255, g = q >> 6, t0 = strip * 8;
    v4u z[8 + W - 1];
    const GAS unsigned char* zb = (const GAS unsigned char*)ZP; const int tb = t0 - (W - 1);
#pragma unroll
    for (int i = 0; i < 8 + W - 1; ++i) { const int t = tb + i; const unsigned off = (unsigned)((t < 0 ? 0 : t) * HW + q * 8) * 2u; const v4u v = *(const GAS v4u*)(zb + off); z[i] = t >= 0 ? v : (v4u){0u, 0u, 0u, 0u}; }
    float s[8] = {0.f, 0.f, 0.f, 0.f, 0.f, 0.f, 0.f, 0.f};
#pragma unroll
    for (int i = 0; i < W - 1; ++i) { s[0] += bflo(z[i].x); s[1] += bfhi(z[i].x); s[2] += bflo(z[i].y); s[3] += bfhi(z[i].y); s[4] += bflo(z[i].z); s[5] += bfhi(z[i].z); s[6] += bflo(z[i].w); s[7] += bfhi(z[i].w); }
#pragma unroll
    for (int r = 0; r < 8; ++r) { const v4u zn = z[W - 1 + r]; const int t = t0 + r;
        const float c[8] = {bflo(zn.x), bfhi(zn.x), bflo(zn.y), bfhi(zn.y), bflo(zn.z), bfhi(zn.z), bflo(zn.w), bfhi(zn.w)};
#pragma unroll
        for (int e = 0; e < 8; ++e) s[e] += c[e];
        const float ic = 1.0f / (float)(t + 1 < W ? t + 1 : W);
        v4u o; o.x = pk2(s[0] * ic - c[0], s[1] * ic - c[1]); o.y = pk2(s[2] * ic - c[2], s[3] * ic - c[3]); o.z = pk2(s[4] * ic - c[4], s[5] * ic - c[5]); o.w = pk2(s[6] * ic - c[6], s[7] * ic - c[7]);
        *(GAS v4u*)(PL + ((size_t)g * SEQ + t) * 512 + (q & 63) * 8) = o;
        const v4u zo = z[r];
        s[0] -= bflo(zo.x); s[1] -= bfhi(zo.x); s[2] -= bflo(zo.y); s[3] -= bfhi(zo.y); s[4] -= bflo(zo.z); s[5] -= bfhi(zo.z); s[6] -= bflo(zo.w); s[7] -= bfhi(zo.w); }
}
__device__ __forceinline__ void p2_prep(Frame& F, const Args& a) {
    unsigned char* ws = a.ws;
    const int gw = F.vcu * NWAVES + F.wave, NGW = F.G * NWAVES, lane = ((int)threadIdx.x & 63);
    {
        const int gt = F.vcu * (NWAVES * 64) + ((int)threadIdx.x), NGT = F.G * NWAVES * 64;
        for (int task = gt; task < (SEQ / 8) * 256; task += NGT) {
            const int q = task & 255, g = q >> 6;
            if (g == 0) pool_task<2>(ws, task); else if (g == 1) pool_task<4>(ws, task); else if (g == 2) pool_task<8>(ws, task); else pool_task<16>(ws, task);
        }
    }
}
__device__ __forceinline__ void p3_cumsum(Frame& F, const Args& a, int h) {
    const float* LF = (const float*)(a.ws + WS_LF) + (size_t)h * SEQ; float* T = (float*)(a.ws + WS_T) + (size_t)h * SEQ;
    LAS float* sh = (LAS float*)F.lds;
    float v[16]; float s = 0.f;
#pragma unroll
    for (int j = 0; j < 4; ++j) { const f32x4 x = *(const GAS f32x4*)(LF + ((int)threadIdx.x) * 16 + 4 * j); v[4 * j] = x.x; v[4 * j + 1] = x.y; v[4 * j + 2] = x.z; v[4 * j + 3] = x.w; }
#pragma unroll
    for (int j = 0; j < 16; ++j) { s += v[j]; v[j] = s; }
    float inc = s;
#pragma unroll
    for (int o = 1; o < 64; o <<= 1) { const float t = __shfl_up(inc, o); if (((int)threadIdx.x & 63) >= o) inc += t; }
    if (((int)threadIdx.x & 63) == 63) sh[F.wave] = inc;
    __syncthreads();
    float off = inc - s;
    for (int w = 0; w < F.wave; ++w) off += sh[w];
    const float k = -1.0f / ATT_SCALE;
#pragma unroll
    for (int j = 0; j < 4; ++j) *(GAS f32x4*)(T + ((int)threadIdx.x) * 16 + 4 * j) = (f32x4){(off + v[4 * j]) * k, (off + v[4 * j + 1]) * k, (off + v[4 * j + 2]) * k, (off + v[4 * j + 3]) * k};
    __syncthreads();
}
__device__ __forceinline__ void ffn_act_phase(Frame& F, const bf16* GU, const float* cw, bf16* ACT) {
    const int gt = F.vcu * (NWAVES * 64) + ((int)threadIdx.x), NGT = F.G * NWAVES * 64;
    constexpr int NCH = DFF / 8, NTASK = (SEQ / 16) * NCH;
    for (int task = gt; task < NTASK; task += NGT) {
        const int strip = task / NCH, q = task - strip * NCH, t0 = strip * 16, gcol = (q >> 4) * 256 + (q & 15) * 8;
        float w0[8], w1[8], w2[8], p2[8], p1[8];
#pragma unroll
        for (int i = 0; i < 8; ++i) { w0[i] = cw[q * 8 + i]; w1[i] = cw[DFF + q * 8 + i]; w2[i] = cw[2 * DFF + q * 8 + i]; p2[i] = 0.f; p1[i] = 0.f; }
        if (t0 > 0) { const v4u a2 = *(const GAS v4u*)(GU + (size_t)(t0 - 2) * (2 * DFF) + gcol), a1 = *(const GAS v4u*)(GU + (size_t)(t0 - 1) * (2 * DFF) + gcol);
            p2[0] = bflo(a2.x); p2[1] = bfhi(a2.x); p2[2] = bflo(a2.y); p2[3] = bfhi(a2.y); p2[4] = bflo(a2.z); p2[5] = bfhi(a2.z); p2[6] = bflo(a2.w); p2[7] = bfhi(a2.w);
            p1[0] = bflo(a1.x); p1[1] = bfhi(a1.x); p1[2] = bflo(a1.y); p1[3] = bfhi(a1.y); p1[4] = bflo(a1.z); p1[5] = bfhi(a1.z); p1[6] = bflo(a1.w); p1[7] = bfhi(a1.w); }
#pragma unroll 4
        for (int t = t0; t < t0 + 16; ++t) {
            const v4u gw_ = *(const GAS v4u*)(GU + (size_t)t * (2 * DFF) + gcol), uw = *(const GAS v4u*)(GU + (size_t)t * (2 * DFF) + gcol + 128);
            const float c[8] = {bflo(gw_.x), bfhi(gw_.x), bflo(gw_.y), bfhi(gw_.y), bflo(gw_.z), bfhi(gw_.z), bflo(gw_.w), bfhi(gw_.w)};
            const float uu[8] = {bflo(uw.x), bfhi(uw.x), bflo(uw.y), bfhi(uw.y), bflo(uw.z), bfhi(uw.z), bflo(uw.w), bfhi(uw.w)};
            float o[8];
#pragma unroll
            for (int i = 0; i < 8; ++i) { const float y = w0[i] * p2[i] + w1[i] * p1[i] + w2[i] * c[i]; o[i] = y / (1.f + __expf(-y)) * uu[i]; p2[i] = p1[i]; p1[i] = c[i]; }
            v4u ov; ov.x = pk2(o[0], o[1]); ov.y = pk2(o[2], o[3]); ov.z = pk2(o[4], o[5]); ov.w = pk2(o[6], o[7]);
            *(GAS v4u*)(ACT + (size_t)t * DFF + q * 8) = ov;
        }
    }
}
__device__ __forceinline__ void act_fixup_panel(Frame& F, int pm, const float* HG, const float* HU, const float* cw, bf16* ACT) {
    constexpr int NQ = DFF / 4, NT = 2 * NQ;
    for (int base = (int)threadIdx.x; base < NT; base += 4 * NWAVES * 64) {
        f32x4 g0[4], gm1[4], gm2[4], w0[4], w1[4], w2[4], uu[4]; const f32x4 z = (f32x4){0.f, 0.f, 0.f, 0.f};
#pragma unroll
        for (int k = 0; k < 4; ++k) { const int idx = base + k * NWAVES * 64; const int id2 = idx < NT ? idx : base; const int i = id2 / NQ, c4 = (id2 - i * NQ) * 4;
            g0[k] = *(const GAS f32x4*)(HG + ((size_t)pm * 4 + i) * DFF + c4);
            const int r1 = i == 0 ? (pm - 1) * 4 + 3 : pm * 4, r2 = i == 0 ? (pm - 1) * 4 + 2 : (pm - 1) * 4 + 3;
            gm1[k] = (i == 0 && pm == 0) ? z : *(const GAS f32x4*)(HG + (size_t)(r1 < 0 ? 0 : r1) * DFF + c4);
            gm2[k] = pm == 0 ? z : *(const GAS f32x4*)(HG + (size_t)(r2 < 0 ? 0 : r2) * DFF + c4);
            w0[k] = *(const GAS f32x4*)(cw + c4); w1[k] = *(const GAS f32x4*)(cw + DFF + c4); w2[k] = *(const GAS f32x4*)(cw + 2 * DFF + c4); uu[k] = *(const GAS f32x4*)(HU + ((size_t)pm * 2 + i) * DFF + c4); }
#pragma unroll
        for (int k = 0; k < 4; ++k) { const int idx = base + k * NWAVES * 64; if (idx < NT) { const int i = idx / NQ, c4 = (idx - i * NQ) * 4;
            float o[4];
#pragma unroll
            for (int e = 0; e < 4; ++e) { const float y = w0[k][e] * gm2[k][e] + w1[k][e] * gm1[k][e] + w2[k][e] * g0[k][e]; o[e] = y * __builtin_amdgcn_rcpf(1.0f + __expf(-y)) * uu[k][e]; }
            *(GAS unsigned long long*)(ACT + (size_t)(pm * 256 + i) * DFF + c4) = (unsigned long long)pk2(o[0], o[1]) | ((unsigned long long)pk2(o[2], o[3]) << 32); } }
    }
}
__device__ __forceinline__ void p12_mixers(Frame& F, const Args& a) {
    unsigned char* ws = a.ws;
    const bf16* P1 = (const bf16*)(ws + WS_P1); const bf16* VST = (const bf16*)(ws + WS_VST); const bf16* WSG = (const bf16*)(ws + WS_WSGU); bf16* CC = (bf16*)(ws + WS_CC);
    const int lane = ((int)threadIdx.x & 63);
    for (int unit = F.vcu; unit < 256; unit += F.G) {
        const int n = unit >> 2, hg = unit & 3;
        LAS float* part = (LAS float*)F.lds;
        LAS float* rs = (LAS float*)(F.lds + 16384);
        { const int tc = ((int)threadIdx.x) & 15, cg = ((int)threadIdx.x) >> 4; float s[8] = {0.f, 0.f, 0.f, 0.f, 0.f, 0.f, 0.f, 0.f};
          const bf16* p = VST + (size_t)(cg * 64) * SEQ + n * 128 + tc * 8;
#pragma unroll 16
          for (int c = 0; c < 64; ++c) { const v4u w = *(const GAS v4u*)(p + (size_t)c * SEQ);
              float f; f = bflo(w.x); s[0] += f * f; f = bfhi(w.x); s[1] += f * f; f = bflo(w.y); s[2] += f * f; f = bfhi(w.y); s[3] += f * f;
              f = bflo(w.z); s[4] += f * f; f = bfhi(w.z); s[5] += f * f; f = bflo(w.w); s[6] += f * f; f = bfhi(w.w); s[7] += f * f; }
#pragma unroll
          for (int i = 0; i < 8; ++i) part[cg * 128 + tc * 8 + i] = s[i]; }
        __syncthreads();
        if (((int)threadIdx.x) < 128) { float s = 0.f; for (int c = 0; c < 32; ++c) s += part[c * 128 + ((int)threadIdx.x)]; rs[((int)threadIdx.x)] = 1.0f / sqrtf(s * (1.f / 2048.f) + EPS); }
        __syncthreads();
        const int h = hg * 4 + (F.wave >> 1), th = F.wave & 1, fr = lane & 15, fq = lane >> 4;
        bf16x8 Af[4][4];
#pragma unroll
        for (int mt = 0; mt < 4; ++mt)
#pragma unroll
            for (int ks = 0; ks < 4; ++ks) { const int t = 64 * th + 16 * mt + fr, s0 = 32 * ks + 8 * fq;
                const v4u w = *(const GAS v4u*)(WSG + ((size_t)h * 128 + t) * 128 + s0);
                v4u o; o.x = pk2(bflo(w.x) * rs[s0], bfhi(w.x) * rs[s0 + 1]); o.y = pk2(bflo(w.y) * rs[s0 + 2], bfhi(w.y) * rs[s0 + 3]);
                o.z = pk2(bflo(w.z) * rs[s0 + 4], bfhi(w.z) * rs[s0 + 5]); o.w = pk2(bflo(w.w) * rs[s0 + 6], bfhi(w.w) * rs[s0 + 7]);
                Af[mt][ks] = __builtin_bit_cast(bf16x8, o); }
        const float* sg = a.in[I_L1_SGUN]; const float* sb = a.in[I_L1_SGUB];
        bf16x8 Bn[4];
#pragma unroll
        for (int ks = 0; ks < 4; ++ks) Bn[ks] = *(const bf16x8*)(VST + (size_t)(h * 128 + fr) * SEQ + n * 128 + 32 * ks + 8 * fq);
        typedef unsigned u32x2 __attribute__((ext_vector_type(2)));
        const size_t trow = (size_t)n * 128 + 64 * th + fr;
        float sbv[4];
#pragma unroll
        for (int mt = 0; mt < 4; ++mt) sbv[mt] = sb[h * 128 + 64 * th + 16 * mt + fr];
#pragma unroll 1
        for (int nt = 0; nt < 8; ++nt) {
            const int c4 = h * 128 + 16 * nt + 4 * fq;
            bf16x8 Bf[4];
#pragma unroll
            for (int ks = 0; ks < 4; ++ks) Bf[ks] = Bn[ks];
            if (nt + 1 < 8) {
#pragma unroll
                for (int ks = 0; ks < 4; ++ks) Bn[ks] = *(const bf16x8*)(VST + (size_t)(h * 128 + 16 * (nt + 1) + fr) * SEQ + n * 128 + 32 * ks + 8 * fq); }
            u32x2 uv[4];
#pragma unroll
            for (int mt = 0; mt < 4; ++mt) uv[mt] = *(const GAS u32x2*)(P1 + (trow + 16 * mt) * 8192 + 6144 + c4);
            const f32x4 gc = *(const GAS f32x4*)(sg + c4);
            f32x4 acc[4];
#pragma unroll
            for (int mt = 0; mt < 4; ++mt) { acc[mt] = (f32x4){0.f, 0.f, 0.f, 0.f};
#pragma unroll
                for (int ks = 0; ks < 4; ++ks) acc[mt] = __builtin_amdgcn_mfma_f32_16x16x32_bf16(Bf[ks], Af[mt][ks], acc[mt], 0, 0, 0); }
#pragma unroll
            for (int mt = 0; mt < 4; ++mt) { const f32x4 mx = acc[mt] * gc + sbv[mt];
                u32x2 o; o.x = pk2(bflo(uv[mt].x) * mx[0], bfhi(uv[mt].x) * mx[1]); o.y = pk2(bflo(uv[mt].y) * mx[2], bfhi(uv[mt].y) * mx[3]);
                *(GAS u32x2*)(CC + (trow + 16 * mt) * DM + HW + c4) = o; }
        }
        __syncthreads();
    }
    {
        const int gt = F.vcu * (NWAVES * 64) + ((int)threadIdx.x), NGT = F.G * NWAVES * 64; const float* cw = a.in[I_L1_CONVW];
        const GAS unsigned char* pb = (const GAS unsigned char*)P1;
        for (int task = gt; task < (SEQ / 8) * 256; task += NGT) {
            const int strip = task >> 8, q = task & 255, t0 = strip * 8;
            v4u vv[10], cc[10], bb[8];
#pragma unroll
            for (int i = 0; i < 10; ++i) { const int t = t0 - 2 + i; const unsigned off = (unsigned)((t < 0 ? 0 : t) * 8192 + q * 8) * 2u;
                vv[i] = *(const GAS v4u*)(pb + off); cc[i] = *(const GAS v4u*)(pb + off + 2 * HW * 2);
                if (i >= 2) bb[i - 2] = *(const GAS v4u*)(pb + off + HW * 2); }
            float w0[8], w1[8], w2[8], p2[8], p1[8];
#pragma unroll
            for (int i = 0; i < 8; ++i) { w0[i] = cw[q * 8 + i]; w1[i] = cw[HW + q * 8 + i]; w2[i] = cw[2 * HW + q * 8 + i]; }
            const float hz = t0 > 0 ? 1.f : 0.f;
#define CVX(V, C, o) { o[0] = bflo(V.x) * bflo(C.x); o[1] = bfhi(V.x) * bfhi(C.x); o[2] = bflo(V.y) * bflo(C.y); o[3] = bfhi(V.y) * bfhi(C.y); o[4] = bflo(V.z) * bflo(C.z); o[5] = bfhi(V.z) * bfhi(C.z); o[6] = bflo(V.w) * bflo(C.w); o[7] = bfhi(V.w) * bfhi(C.w); }
            CVX(vv[0], cc[0], p2); CVX(vv[1], cc[1], p1);
#pragma unroll
            for (int i = 0; i < 8; ++i) { p2[i] *= hz; p1[i] *= hz; }
#pragma unroll
            for (int r = 0; r < 8; ++r) { float cur[8]; CVX(vv[r + 2], cc[r + 2], cur);
                const v4u bw = bb[r]; const float gb[8] = {bflo(bw.x), bfhi(bw.x), bflo(bw.y), bfhi(bw.y), bflo(bw.z), bfhi(bw.z), bflo(bw.w), bfhi(bw.w)};
                float o[8];
#pragma unroll
                for (int i = 0; i < 8; ++i) { o[i] = gb[i] * (w0[i] * p2[i] + w1[i] * p1[i] + w2[i] * cur[i]); p2[i] = p1[i]; p1[i] = cur[i]; }
                v4u ov; ov.x = pk2(o[0], o[1]); ov.y = pk2(o[2], o[3]); ov.z = pk2(o[4], o[5]); ov.w = pk2(o[6], o[7]);
                *(GAS v4u*)(CC + (size_t)(t0 + r) * DM + q * 8) = ov; }
#undef CVX
        }
    }
}
constexpr int CW_ATTQ = 8192;
__device__ __forceinline__ void p4_attention(Frame& F, const Args& a, char* lds) {
    unsigned char* ws = a.ws; gu32* ctl = (gu32*)(ws + WS_CTL);
    const fox::bf16* Qb = (const fox::bf16*)(ws + WS_QKV); const fox::bf16* Kb = Qb + (size_t)NH * SEQ * 128; const fox::bf16* Vb = Kb + (size_t)NH * SEQ * 128;
    fox::bf16* CC = (fox::bf16*)(ws + WS_CC); const float* T = (const float*)(ws + WS_T);
    const int tid = (int)threadIdx.x, lane = tid & 63;
    volatile LAS unsigned* qw = (volatile LAS unsigned*)(F.lds + fox::LDS_ATT);
    { float cb; float mq = fmaxf(fabsf(a.in[I_L0_QG][lane]), fabsf(a.in[I_L0_QG][lane + 64])), mk = fmaxf(fabsf(a.in[I_L0_KG][lane]), fabsf(a.in[I_L0_KG][lane + 64]));
#pragma unroll
      for (int o = 1; o < 64; o <<= 1) { mq = fmaxf(mq, __shfl_xor(mq, o)); mk = fmaxf(mk, __shfl_xor(mk, o)); }
      const float bqk = 128.0f * mq * mk * ATT_SCALE * 1.02f; cb = (120.0f + 2.0f * bqk) * (1.0f / ATT_SCALE); if (tid == 0) qw[3] = __builtin_bit_cast(unsigned, cb); }
    for (;;) {
        int tv = (int)threadIdx.x; asm volatile("" : "+v"(tv));
        const int lane_ = tv & 63;
        if (tv == 0) qw[0] = __hip_atomic_fetch_add(ctl + CW_ATTQ, 1u, RLX_AGENT);
        __syncthreads();
        const int item = __builtin_amdgcn_readfirstlane((int)qw[0]);
        if (item >= 2 * 256) break;
        const int h = item & 15, qb = 31 - (item >> 4), P0 = qb * 256, ntf = (P0 + 256) / 64;
        const float* Th = T + (size_t)h * SEQ;
        if (tv < 128) { const float tp0 = Th[P0]; const float cb = __builtin_bit_cast(float, (unsigned)qw[3]); const bool skip = (tv < ntf - 4) && (Th[64 * tv + 63] < tp0 - cb);
            const unsigned long long m = __ballot(skip); if (lane_ == 0) qw[1 + (tv >> 6)] = (unsigned)__popcll(m); }
        __syncthreads();
        const int jlo = __builtin_amdgcn_readfirstlane((int)(qw[1] + qw[2]));
        { const GAS f32x4* src = (const GAS f32x4*)Th; LAS f32x4* dst = (LAS f32x4*)((LAS unsigned char*)F.lds + fox::LDS_T);
          for (int e = jlo * 16 + tv; e < ntf * 16; e += NWAVES * 64) dst[e] = src[e]; }
        fox::BlockRef r; r.Q = Qb + ((size_t)h * SEQ + P0) * 128; r.K = Kb + (size_t)h * SEQ * 128; r.V = Vb + (size_t)h * SEQ * 128; r.O = CC + (size_t)P0 * DM + h * 128; r.P0 = P0; r.jlo = jlo;
        fox::Seam S;
        fox::fox_prime(r, lds, S, tv);
        fox::fox_block(r, r, lds, S, tv);
    }
}
#ifndef MK_N_LAUNCHES
#define MK_N_LAUNCHES 1
#endif
constexpr int NPHASES = 12;
#ifndef GEMM_SP2
#define GEMM_SP2 true
#endif
#ifndef PHM
#define PHM 0xFFFFFFFFu
#endif
#define PM(k) ((PHM >> (k)) & 1u)
__global__ void __launch_bounds__(NWAVES * 64, 2) fwd(Args args) {
    extern __shared__ __attribute__((aligned(16))) unsigned char lds[];
    Frame F;
    F.lds = (LAS unsigned char*)lds;
    F.MISC = (volatile LAS unsigned*)(F.lds + MISC_OFF);
    F.wave = __builtin_amdgcn_readfirstlane((int)threadIdx.x >> 6);
    F.G = gridDim.x; { const int bx = blockIdx.x; F.vcu = (F.G % 8 == 0) ? (bx % 8) * (F.G / 8) + bx / 8 : bx; }
    unsigned char* ws = args.ws;
    gu32* ctl = (gu32*)(ws + WS_CTL);
    for (int u = ((int)threadIdx.x); u < (LDS_BYTES - LDSCTL_OFF) / 4; u += NWAVES * 64) ((LAS unsigned*)(F.lds + LDSCTL_OFF))[u] = 0u;
    __syncthreads();
    const int lo = args.ph_lo, hi = args.ph_hi;
    XcdBarrier bar; bar.bar = (unsigned*)(ctl + CW_BAR); bar.x = 0; bar.st = nullptr;
    if (hi - lo > 1) bar = xcd_barrier_post((unsigned*)(ctl + CW_BAR), F.MISC + 8);
    int ph = 0;
#define PH_ON (ph >= lo && ph < hi)
#define PH_END do { if (ph + 1 < hi) xcd_barrier(bar); } while (0)
    bf16* XN = (bf16*)(ws + WS_XN); bf16* CC = (bf16*)(ws + WS_CC); bf16* GU = (bf16*)(ws + WS_GU); bf16* ACT = (bf16*)(ws + WS_ACT);
    float* X = args.out;
    typedef pg8::StaticOrder SO;
#define GEMM_PHASE(EPI, EINIT, AP, BP, MM, NN, KK) do { pg8::Gemm g{AP, BP, MM, NN, KK}; SO S; S.init(MM, NN, F.G, (int)blockIdx.x); EPI E EINIT; pg8::gemm_phase<EPI, SO, true, GEMM_SP2>(F.lds, g, S, E); } while (0)

    if (PM(0) && PH_ON) { p0_prologue(F, args); PH_END; } ++ph;
    if (PM(2) && PH_ON) {
        constexpr int GW0 = 176;
        if (F.G != 256) { p_logits(args, (int)blockIdx.x * NWAVES + F.wave, F.G * NWAVES); cv_queue(F, args); VM_WAIT(); __syncthreads(); GEMM_PHASE(pg8::EpiQKVZ, ({(bf16*)(ws + WS_QKV), (bf16*)(ws + WS_ZP), pg8::RowScale{(const float*)(ws + WS_SSP), 1, (LAS float*)(F.lds + RR_OFF)}, args.in[I_L0_QG], args.in[I_L0_KG], (LAS float*)(F.lds + RED_OFF)}), XN, (const bf16*)(ws + WS_W0IN), SEQ, 8192, DM); }
        else {
            if ((int)blockIdx.x < GW0) { pg8::Gemm g{XN, (const bf16*)(ws + WS_W0IN), SEQ, 8192, DM}; SO S; S.init(SEQ, 8192, GW0, (int)blockIdx.x);
                pg8::EpiQKVZ E{(bf16*)(ws + WS_QKV), (bf16*)(ws + WS_ZP), pg8::RowScale{(const float*)(ws + WS_SSP), 1, (LAS float*)(F.lds + RR_OFF)}, args.in[I_L0_QG], args.in[I_L0_KG], (LAS float*)(F.lds + RED_OFF)};
                pg8::gemm_phase<pg8::EpiQKVZ, SO, true, true>(F.lds, g, S, E); }
            else p_logits(args, ((int)blockIdx.x - GW0) * NWAVES + F.wave, (256 - GW0) * NWAVES);
            cv_queue(F, args);
        }
        PH_END; } ++ph;
    if (PM(3) && PH_ON) { if (F.vcu < NH) p3_cumsum(F, args, F.vcu); p2_prep(F, args); PH_END; } ++ph;
    if (PM(4) && PH_ON) { {
        pg8::Gemm g{(const bf16*)(ws + WS_PL), (const bf16*)(ws + WS_WPOOL), 4 * SEQ, 2048, 512}; pg8::PoolOrder S{F.G, (int)blockIdx.x};
        pg8::EpiPool E{CC, DM, args.in[I_L0_POOLS]};
        pg8::gemm_phase<pg8::EpiPool, pg8::PoolOrder, true, true>(F.lds, g, S, E); }
        }
    if (PM(5) && PH_ON) { p4_attention(F, args, (char*)lds); PH_END; } ++ph;
    if (PM(7) && PH_ON) { GEMM_PHASE(pg8::EpiResB<0>, ({args.in[I_X], nullptr, XN, DM, (float*)(ws + WS_SSP), (LAS float*)(F.lds + RED_OFF)}), CC, (const bf16*)(ws + WS_W0OUT), SEQ, DM, DM);  PH_END; } ++ph;
    if (PM(9) && PH_ON) {
        GEMM_PHASE(pg8::EpiAct, ({ACT, args.in[I_L0_FCONV], (float*)(ws + WS_HG), (float*)(ws + WS_HU), (LAS float*)(F.lds + HALO_OFF), pg8::RowScale{(const float*)(ws + WS_SSP), 16, (LAS float*)(F.lds + RR_OFF)}}), XN, (const bf16*)(ws + WS_W0UP), SEQ, 2 * DFF, DM); if (F.G == 256 && blockIdx.x >= 192) cv_static(F, args, CV_NITEMS, CV_TAIL, (int)blockIdx.x - 192, 64); else if (F.G != 256) cv_static(F, args, CV_NITEMS, CV_TAIL, (int)blockIdx.x, F.G);
        PH_END; } ++ph;
    if (PM(11) && PH_ON) {
        { SO S; S.init(SEQ, DM, F.G, (int)blockIdx.x); pg8::Unit u; int last = -1;
          for (int i = 0; S.next(i, u); ++i) if (u.pm != last) { act_fixup_panel(F, u.pm, (const float*)(ws + WS_HG), (const float*)(ws + WS_HU), args.in[I_L0_FCONV], ACT); last = u.pm; }
          VM_WAIT(); __syncthreads(); }
        GEMM_PHASE(pg8::EpiResB<1>, ({nullptr, nullptr, XN, DM, (float*)(ws + WS_SSP), (LAS float*)(F.lds + RED_OFF)}), ACT, (const bf16*)(ws + WS_W0DN), SEQ, DM, DFF);  PH_END; } ++ph;
    if (PM(12) && PH_ON) { {
        GEMM_PHASE(pg8::EpiBf16G<2>, ({(bf16*)(ws + WS_P1), 8192, pg8::RowScale{(const float*)(ws + WS_SSP), 16, (LAS float*)(F.lds + RR_OFF)}}), XN, (const bf16*)(ws + WS_W1IN), SEQ, 8192, DM);
        GEMM_PHASE(pg8::EpiBf16G<1>, ({(bf16*)(ws + WS_VST), SEQ, pg8::RowScale{(const float*)(ws + WS_SSP), 16, (LAS float*)(F.lds + RR_OFF)}}), (const bf16*)(ws + WS_W1IN) + (size_t)8192 * DM, XN, 2048, SEQ, DM); }

        PH_END;
    } ++ph;
    if (PM(6) && PH_ON) { p12_mixers(F, args); PH_END; } ++ph;
    if (PM(13) && PH_ON) { GEMM_PHASE(pg8::EpiResB<1>, ({nullptr, nullptr, XN, DM, (float*)(ws + WS_SSP), (LAS float*)(F.lds + RED_OFF)}), CC, (const bf16*)(ws + WS_W1OUT), SEQ, DM, DM); PH_END; } ++ph;
    if (PM(15) && PH_ON) { GEMM_PHASE(pg8::EpiAct, ({ACT, args.in[I_L1_FCONV], (float*)(ws + WS_HG), (float*)(ws + WS_HU), (LAS float*)(F.lds + HALO_OFF), pg8::RowScale{(const float*)(ws + WS_SSP), 16, (LAS float*)(F.lds + RR_OFF)}}), XN, (const bf16*)(ws + WS_W1UP), SEQ, 2 * DFF, DM); if (F.G == 256 && blockIdx.x >= 192) convert_w1dn(F, args, (int)blockIdx.x - 192, 64); else if (F.G != 256) convert_w1dn(F, args, (int)blockIdx.x, F.G); PH_END; } ++ph;
    if (PM(17) && PH_ON) {
        { SO S; S.init(SEQ, DM, F.G, (int)blockIdx.x); pg8::Unit u; int last = -1;
          for (int i = 0; S.next(i, u); ++i) if (u.pm != last) { act_fixup_panel(F, u.pm, (const float*)(ws + WS_HG), (const float*)(ws + WS_HU), args.in[I_L1_FCONV], ACT); last = u.pm; }
          VM_WAIT(); __syncthreads(); }
        GEMM_PHASE(pg8::EpiResB<2>, ({nullptr, X, XN, DM, nullptr, nullptr}), ACT, (const bf16*)(ws + WS_W1DN), SEQ, DM, DFF); PH_END; } ++ph;
#undef PH_ON
#undef PH_END
#undef GEMM_PHASE
}

extern "C" void kernel_launch(void* const* d_in, const int* in_sizes, int n_in, void* d_out, int out_size, void* d_ws, size_t ws_size, hipStream_t stream) {
    static int grid = 0;
    if (grid == 0) {
        if (n_in != 24 || in_sizes[0] != SEQ * DM || out_size != SEQ * DM || ws_size < WS_END) { fprintf(stderr, "kernel_launch: unexpected shapes (n_in %d, in0 %d, out %d, ws %zu < %zu); nothing launched\n", n_in, n_in > 0 ? in_sizes[0] : -1, out_size, ws_size, (size_t)WS_END); grid = -1; return; }
        int dev = 0, cus = 0, per_cu = 0;
        if (hipGetDevice(&dev) != hipSuccess || hipDeviceGetAttribute(&cus, hipDeviceAttributeMultiprocessorCount, dev) != hipSuccess) { grid = -1; return; }
        if (hipFuncSetAttribute((const void*)fwd, hipFuncAttributeMaxDynamicSharedMemorySize, LDS_BYTES) != hipSuccess) { fprintf(stderr, "kernel_launch: hipFuncSetAttribute failed\n"); grid = -1; return; }
        if (hipOccupancyMaxActiveBlocksPerMultiprocessor(&per_cu, (const void*)fwd, NWAVES * 64, LDS_BYTES) != hipSuccess || per_cu < 1) { fprintf(stderr, "kernel_launch: occupancy query reports %d blocks per CU\n", per_cu); }
        (void)hipGetLastError();
        grid = cus;
    }
    if (grid < 0) return;
    if (hipMemsetAsync((char*)d_ws + WS_CTL, 0, CTL_ZERO_BYTES, stream) != hipSuccess) return;
    Args a{};
    for (int i = 0; i < 24; ++i) a.in[i] = (const float*)d_in[i];
    a.out = (float*)d_out; a.ws = (unsigned char*)d_ws;
    for (int li = 0; li < MK_N_LAUNCHES; ++li) {
        a.ph_lo = (MK_N_LAUNCHES == 1) ? 0 : li; a.ph_hi = (MK_N_LAUNCHES == 1) ? NPHASES : li + 1;
        hipLaunchKernelGGL(fwd, dim3(grid), dim3(NWAVES * 64), LDS_BYTES, stream, a);
        const hipError_t le = hipPeekAtLastError();
        if (le != hipSuccess) { fprintf(stderr, "kernel_launch: launch %d failed: %s\n", li, hipGetErrorName(le)); break; }
    }
}
```
